# Optimizing an MI355X kernel written in HIP

```python
import math
import jax, jax.numpy as jnp
from jax import lax
import numpy as np

D_MODEL = 2048
BATCH = 8
SEQ = 4096
DEPTH = 1

GRID_W = 64
NA_HEADS = 16
NA_HEAD_DIM = 64
NA_WIDTH = NA_HEADS * NA_HEAD_DIM
NA_WIN_ROWS = 8
NA_WIN_COLS = 16
NA_QBLOCK_COLS = 16
NA_KBLOCK_COLS = NA_QBLOCK_COLS + NA_WIN_COLS
ML_HEADS = 4
ML_HEAD_DIM = 256
ML_WIDTH = ML_HEADS * ML_HEAD_DIM
ML_CHUNK = 128
CONV_WIDTH = 3
D_FF = 5504
LN_EPS = 1e-5
NEG_BIG = -1e30
DEEPNORM_ALPHA = (2 * DEPTH) ** 0.25
DEEPNORM_BETA = (8 * DEPTH) ** -0.25
IN_SIZES = (3 * NA_WIDTH, ML_WIDTH, ML_WIDTH, ML_WIDTH, ML_WIDTH, 4 * ML_HEADS, 2 * D_MODEL)
IN_WIDTH = sum(IN_SIZES)
IN_SPLIT_POINTS = tuple(int(v) for v in np.cumsum(IN_SIZES)[:-1])

kernel_name = "hybrid_natten_mlstm_convglu_deepnorm"


def layer_norm(x, g, b):
    xf = x.astype(jnp.float32)
    mu = jnp.mean(xf, axis=-1, keepdims=True)
    var = jnp.mean(jnp.square(xf - mu), axis=-1, keepdims=True)
    y = (xf - mu) * lax.rsqrt(var + LN_EPS)
    return (y * g + b).astype(x.dtype)


def dwconv_centred(x, w, b):
    s = x.shape[1]
    pad = CONV_WIDTH // 2
    xp = jnp.pad(x, ((0, 0), (pad, pad), (0, 0)))
    y = xp[:, 0:s] * w[0]
    for i in range(1, CONV_WIDTH):
        y = y + xp[:, i:i + s] * w[i]
    return y + b


def neighborhood_attention(q, k, v, rpb):
    bsz, s, h, d = q.shape
    rows = s // GRID_W
    kh = min(NA_WIN_ROWS, rows)
    nqb = GRID_W // NA_QBLOCK_COLS

    def to_grid(t):
        return t.reshape(bsz, rows, GRID_W, h, d).transpose(0, 3, 1, 2, 4)

    qg = to_grid(q) * (d ** -0.5)
    kg = to_grid(k)
    vg = to_grid(v)

    qcol = np.arange(GRID_W).reshape(nqb, NA_QBLOCK_COLS)
    kstart = np.clip(qcol[:, 0] - NA_WIN_COLS // 2, 0, GRID_W - NA_KBLOCK_COLS)
    kcol = kstart[:, None] + np.arange(NA_KBLOCK_COLS)
    wstart = np.clip(qcol - NA_WIN_COLS // 2, 0, GRID_W - NA_WIN_COLS)
    col_valid = (kcol[:, None, :] >= wstart[..., None]) & (kcol[:, None, :] < wstart[..., None] + NA_WIN_COLS)
    dc_idx = np.clip(kcol[:, None, :] - qcol[:, :, None] + NA_WIN_COLS - 1, 0, 2 * NA_WIN_COLS - 2)
    col_bias = rpb[:, :, dc_idx]
    valid = jnp.asarray(col_valid)[:, :, None, :]

    def row_step(r):
        rs = jnp.clip(r - kh // 2, 0, rows - kh)
        krows = lax.dynamic_slice_in_dim(kg, rs, kh, axis=2)
        vrows = lax.dynamic_slice_in_dim(vg, rs, kh, axis=2)
        kb = krows[:, :, :, kcol, :]
        vb = vrows[:, :, :, kcol, :]
        qr = lax.dynamic_index_in_dim(qg, r, axis=2, keepdims=False).reshape(bsz, h, nqb, NA_QBLOCK_COLS, d)
        sc = jnp.einsum('bhjqd,bhrjkd->bhjqrk', qr, kb).astype(jnp.float32)
        dr_idx = rs + jnp.arange(kh) - r + (NA_WIN_ROWS - 1)
        bias = jnp.take(col_bias, dr_idx, axis=1).transpose(0, 2, 3, 1, 4)
        sc = jnp.where(valid, sc + bias.astype(jnp.float32), NEG_BIG)
        p = jax.nn.softmax(sc.reshape(bsz, h, nqb, NA_QBLOCK_COLS, kh * NA_KBLOCK_COLS), axis=-1)
        p = p.reshape(sc.shape).astype(vb.dtype)
        o = jnp.einsum('bhjqrk,bhrjkd->bhjqd', p, vb)
        return o.reshape(bsz, h, GRID_W, d)

    out = lax.map(row_step, jnp.arange(rows))
    return out.transpose(1, 0, 3, 2, 4).reshape(bsz, s, h * d)


def mlstm_chunkwise(q, k, v, logi, logf):
    g, bsz, h, s, dk = q.shape
    dv = v.shape[-1]
    nc = s // ML_CHUNK

    def chunks(t):
        return jnp.moveaxis(t.reshape(t.shape[:3] + (nc, ML_CHUNK) + t.shape[4:]), 3, 0)

    tri = jnp.tril(jnp.ones((ML_CHUNK, ML_CHUNK), dtype=bool))

    def step(carry, xs):
        c_st, n_st, m_st = carry
        qc, kc, vc, li, lf = xs
        b = jnp.cumsum(lf, axis=-1)
        dlog = jnp.where(tri, b[..., :, None] - b[..., None, :] + li[..., None, :], NEG_BIG)
        inter = b + m_st[..., None]
        m_t = jnp.maximum(jnp.max(dlog, axis=-1), inter)
        dw = jnp.exp(dlog - m_t[..., None])
        w_inter = jnp.exp(inter - m_t)
        sqk = jnp.einsum('gbhtd,gbhsd->gbhts', qc, kc) * dw
        num = w_inter[..., None] * jnp.einsum('gbhtd,gbhde->gbhte', qc, c_st) + jnp.einsum('gbhts,gbhse->gbhte', sqk, vc)
        den = w_inter * jnp.einsum('gbhtd,gbhd->gbht', qc, n_st) + jnp.sum(sqk, axis=-1)
        hc = num / jnp.maximum(jnp.abs(den), jnp.exp(-m_t))[..., None]
        b_last = b[..., -1]
        logw = b_last[..., None] - b + li
        m_new = jnp.maximum(b_last + m_st, jnp.max(logw, axis=-1))
        ws = jnp.exp(logw - m_new[..., None])
        decay = jnp.exp(b_last + m_st - m_new)
        kw = kc * ws[..., None]
        c_new = decay[..., None, None] * c_st + jnp.einsum('gbhsd,gbhse->gbhde', kw, vc)
        n_new = decay[..., None] * n_st + jnp.sum(kw, axis=-2)
        return (c_new, n_new, m_new), hc

    init = (jnp.zeros((g, bsz, h, dk, dv), jnp.float32),
            jnp.zeros((g, bsz, h, dk), jnp.float32),
            jnp.full((g, bsz, h), NEG_BIG, jnp.float32))
    _, hs = lax.scan(step, init, (chunks(q), chunks(k), chunks(v), chunks(logi), chunks(logf)))
    return jnp.moveaxis(hs, 0, 3).reshape(g, bsz, h, s, dv)


def mlstm_branch(q_pre, k_pre, v_in, o_pre, gate_pre, conv_w, conv_b, igate_b, fgate_b, norm_w):
    bsz, s, _ = q_pre.shape
    qk = jax.nn.silu(dwconv_centred(jnp.concatenate([q_pre, k_pre], axis=-1), conv_w, conv_b))
    q, k = jnp.split(qk, 2, axis=-1)

    def heads(t):
        return t.reshape(bsz, s, ML_HEADS, ML_HEAD_DIM).transpose(0, 2, 1, 3).astype(jnp.float32)

    q = heads(q)
    k = heads(k) * (ML_HEAD_DIM ** -0.5)
    v = heads(v_in)
    gp = gate_pre.astype(jnp.float32)
    ig = (gp[..., :2 * ML_HEADS] + igate_b).reshape(bsz, s, 2, ML_HEADS).transpose(2, 0, 3, 1)
    fg = (gp[..., 2 * ML_HEADS:] + fgate_b).reshape(bsz, s, 2, ML_HEADS).transpose(2, 0, 3, 1)
    logf = jax.nn.log_sigmoid(fg)
    flip = lambda t: jnp.flip(t, axis=2)
    q2 = jnp.stack([q, flip(q)])
    k2 = jnp.stack([k, flip(k)])
    v2 = jnp.stack([v, flip(v)])
    li2 = jnp.stack([ig[0], flip(ig[1])])
    lf2 = jnp.stack([logf[0], flip(logf[1])])
    h2 = mlstm_chunkwise(q2, k2, v2, li2, lf2)
    hsum = h2[0] + jnp.flip(h2[1], axis=2)
    mu = jnp.mean(hsum, axis=-1, keepdims=True)
    var = jnp.mean(jnp.square(hsum - mu), axis=-1, keepdims=True)
    hn = (hsum - mu) * lax.rsqrt(var + LN_EPS) * norm_w.reshape(ML_HEADS, 1, ML_HEAD_DIM)
    hn = hn.transpose(0, 2, 1, 3).reshape(bsz, s, ML_WIDTH).astype(q_pre.dtype)
    return hn * jax.nn.sigmoid(o_pre)


def conv_glu(x, w_up, conv_w, conv_b, w_down):
    u = x @ w_up
    gate, val = jnp.split(u, 2, axis=-1)
    a = jax.nn.gelu(dwconv_centred(gate, conv_w, conv_b), approximate=False)
    return (a * val) @ w_down


def setup_inputs(seed: int = 0) -> dict:
    key = jax.random.key(seed)
    ks = jax.random.split(key, 20)
    f32 = jnp.float32
    nrm = lambda k, shape, sc: jax.random.normal(k, shape, f32) * sc
    L = DEPTH
    return {
        "x": nrm(ks[0], (BATCH, SEQ, D_MODEL), 1.0),
        "w_in": nrm(ks[1], (L, D_MODEL, IN_WIDTH), D_MODEL ** -0.5),
        "na_rpb": nrm(ks[2], (L, NA_HEADS, 2 * NA_WIN_ROWS - 1, 2 * NA_WIN_COLS - 1), 0.1),
        "ml_conv_w": nrm(ks[3], (L, CONV_WIDTH, 2 * ML_WIDTH), CONV_WIDTH ** -0.5),
        "ml_conv_b": nrm(ks[4], (L, 2 * ML_WIDTH), 0.02),
        "ml_igate_b": nrm(ks[5], (L, 2 * ML_HEADS), 0.1),
        "ml_fgate_b": jnp.linspace(3.0, 6.0, 2 * ML_HEADS, dtype=f32)[None, :] + nrm(ks[6], (L, 2 * ML_HEADS), 0.1),
        "ml_norm_w": 1.0 + nrm(ks[7], (L, ML_WIDTH), 0.1),
        "w_branch_na": nrm(ks[8], (L, NA_WIDTH, D_MODEL), NA_WIDTH ** -0.5),
        "w_branch_ml": nrm(ks[9], (L, ML_WIDTH, D_MODEL), ML_WIDTH ** -0.5),
        "w_out": nrm(ks[10], (L, D_MODEL, D_MODEL), D_MODEL ** -0.5 * DEEPNORM_BETA),
        "ln1_g": 1.0 + nrm(ks[11], (L, D_MODEL), 0.1),
        "ln1_b": nrm(ks[12], (L, D_MODEL), 0.02),
        "ffn_w_up": nrm(ks[13], (L, D_MODEL, 2 * D_FF), D_MODEL ** -0.5),
        "ffn_conv_w": nrm(ks[14], (L, CONV_WIDTH, D_FF), CONV_WIDTH ** -0.5),
        "ffn_conv_b": nrm(ks[15], (L, D_FF), 0.02),
        "ffn_w_down": nrm(ks[16], (L, D_FF, D_MODEL), D_FF ** -0.5 * DEEPNORM_BETA),
        "ln2_g": 1.0 + nrm(ks[17], (L, D_MODEL), 0.1),
        "ln2_b": nrm(ks[18], (L, D_MODEL), 0.02),
    }


def reference(x, w_in, na_rpb, ml_conv_w, ml_conv_b, ml_igate_b, ml_fgate_b, ml_norm_w,
              w_branch_na, w_branch_ml, w_out, ln1_g, ln1_b, ffn_w_up, ffn_conv_w, ffn_conv_b,
              ffn_w_down, ln2_g, ln2_b):
    bsz, s, _ = x.shape
    for l in range(DEPTH):
        hproj = x @ w_in[l]
        na_qkv, ml_q, ml_k, ml_v, ml_o, ml_gates, merge_g = jnp.split(hproj, IN_SPLIT_POINTS, axis=-1)
        na_qkv = na_qkv.reshape(bsz, s, 3, NA_HEADS, NA_HEAD_DIM)
        y_na = neighborhood_attention(na_qkv[:, :, 0], na_qkv[:, :, 1], na_qkv[:, :, 2], na_rpb[l])
        y_ml = mlstm_branch(ml_q, ml_k, ml_v, ml_o, ml_gates, ml_conv_w[l], ml_conv_b[l],
                            ml_igate_b[l], ml_fgate_b[l], ml_norm_w[l])
        g_na, g_ml = jnp.split(jax.nn.sigmoid(merge_g), 2, axis=-1)
        mixed = g_na * (y_na @ w_branch_na[l]) + g_ml * (y_ml @ w_branch_ml[l])
        x = layer_norm(DEEPNORM_ALPHA * x + mixed @ w_out[l], ln1_g[l], ln1_b[l])
        f = conv_glu(x, ffn_w_up[l], ffn_conv_w[l], ffn_conv_b[l], ffn_w_down[l])
        x = layer_norm(DEEPNORM_ALPHA * x + f, ln2_g[l], ln2_b[l])
    return x
```

```cpp
#include <hip/hip_runtime.h>
#include <hip/hip_cooperative_groups.h>
#include <cstdio>
#include <cstdint>
namespace cg = cooperative_groups;
#ifndef MK_N_LAUNCHES
#define MK_N_LAUNCHES 1
#endif
namespace pg8 {
#define PG8_LAS __attribute__((address_space(3)))
typedef unsigned short bf16_t;
typedef short bf16x8 __attribute__((ext_vector_type(8)));
typedef float f32x4 __attribute__((ext_vector_type(4)));
typedef unsigned u32x4 __attribute__((ext_vector_type(4)));
constexpr int BM = 256, BK = 64, HALF = 128, HTB = HALF * BK * 2  , STAGE_BYTES = 8 * HTB, NXCD = 8, WGM = 8;

__host__ __device__ __forceinline__ int lds_byte(int r, int c) { const int st = (r >> 4) * 2 + (c >> 5), rr = r & 15, cc = c & 31, ob = rr * 64 + cc * 2; return st * 1024 + (ob ^ (((ob >> 9) & 1) << 5)); }
__host__ __device__ __forceinline__ void stage_rc(int b, int& R, int& C) { const int st = b / 1024, sb = b % 1024, swz = sb ^ (((sb >> 9) & 1) << 5); R = (st >> 1) * 16 + swz / 64; C = (st & 1) * 32 + (swz % 64) / 2; }
__host__ __device__ __forceinline__ int perm32(int rho) { const int n = rho >> 4, i = rho & 15; return 8 * (i >> 2) + 4 * n + (i & 3); }

struct Unit { int pm, pn, seg; };
struct Gemm { const bf16_t* A; const bf16_t* Bt; int M, N, K; const bf16_t* A2; const bf16_t* Bt2; };

struct StaticOrder {
    int nM, nN, nwg, G, c;
    __host__ __device__ void init(int M, int N, int G_, int c_) { nM = M / BM; nN = N / BM; nwg = nM * nN; G = G_; c = c_; }
    __host__ __device__ bool next(int i, Unit& u) const {
        const long L = (long)i * G + c; if (L >= nwg) return false;
        int wgid = (int)L; { const int q = nwg / NXCD, r = nwg % NXCD, xcd = wgid % NXCD, off = wgid / NXCD; wgid = (xcd < r ? xcd * (q + 1) : r * (q + 1) + (xcd - r) * q) + off; }
        const int nig = WGM * nN, gid = wgid / nig, fm = gid * WGM, gsz = (nM - fm) < WGM ? (nM - fm) : WGM;
        u.pm = fm + ((wgid % nig) % gsz); u.pn = (wgid % nig) / gsz; u.seg = 0; return true;
    }
    __device__ __forceinline__ void a_ready(const Unit&) const {}
    __device__ __forceinline__ void done(const Unit&) const {}
};

__device__ __forceinline__ unsigned cvt_pk_bf16(float lo, float hi) { unsigned r; asm volatile("v_cvt_pk_bf16_f32 %0, %1, %2" : "=v"(r) : "v"(lo), "v"(hi)); return r; }
typedef float f32x2 __attribute__((ext_vector_type(2)));
template <class Epi, class Sched, bool ALIGN_EPI = false, bool SP2 = false>
__device__ __forceinline__ void gemm_phase(PG8_LAS unsigned char* lds, const Gemm g, const Sched& S, const Epi& E) {
    const int tid = threadIdx.x, wid = __builtin_amdgcn_readfirstlane(tid >> 6), lane = tid & 63, wr = wid >> 2, wc = wid & 3, fr = lane & 15, fq = lane >> 4;
    const int K = g.K, nt = K / BK;
    unsigned voffA[2], voffB[2];
#pragma unroll
    for (int i = 0; i < 2; ++i) { int R, C; stage_rc(tid * 16 + i * 8192, R, C); const int Rb = Epi::PERM ? ((R & ~31) + perm32(R & 31)) : R;
        voffA[i] = (unsigned)(R * K + C) * 2u; voffB[i] = (unsigned)(Rb * K + C) * 2u; }
    const size_t kstep = (size_t)(BK * 2);
    const size_t hstep = (size_t)HALF * K * 2;
    const size_t tstep = 2 * hstep;
    const unsigned ldsw = (unsigned)wid * 1024u;
    const int aoff = lds_byte(wr * 64 + fr, fq * 8), boff = lds_byte(wc * 32 + fr, fq * 8);
#define PG8_SA(b, h) (((b) * 2 + (h)) * HTB)
#define PG8_SB(b, h) ((4 + (b) * 2 + (h)) * HTB)
#define PG8_STAGE(bufoff, gbase, voff) do { _Pragma("unroll") for (int _i = 0; _i < 2; ++_i) \
        __builtin_amdgcn_global_load_lds((const unsigned*)((const char*)(gbase) + (voff)[_i]), (PG8_LAS unsigned*)(lds + (bufoff) + ldsw + _i * 8192), 16, 0, 0); } while (0)
#define PG8_LDA(dst, b, h) do { _Pragma("unroll") for (int m = 0; m < 4; ++m) _Pragma("unroll") for (int k = 0; k < 2; ++k) dst[m][k] = *(const PG8_LAS bf16x8*)(lds + PG8_SA(b, h) + aoff + m * 2048 + k * 1024); } while (0)
#define PG8_LDB(dst, b, h) do { _Pragma("unroll") for (int n = 0; n < 2; ++n) _Pragma("unroll") for (int k = 0; k < 2; ++k) dst[n][k] = *(const PG8_LAS bf16x8*)(lds + PG8_SB(b, h) + boff + n * 2048 + k * 1024); } while (0)
#define PG8_MMA(ai, bj, At, Bt) do { __builtin_amdgcn_s_setprio(1); _Pragma("unroll") for (int m = 0; m < 4; ++m) _Pragma("unroll") for (int n = 0; n < 2; ++n) _Pragma("unroll") for (int k = 0; k < 2; ++k) \
        acc[ai][bj][m][n] = __builtin_amdgcn_mfma_f32_16x16x32_bf16(Bt[n][k], At[m][k], acc[ai][bj][m][n], 0, 0, 0); __builtin_amdgcn_s_setprio(0); } while (0)
#define PG8_WAIT_V(n) asm volatile("s_waitcnt vmcnt(" #n ")" ::: "memory")
#define PG8_WAIT_L(n) asm volatile("s_waitcnt lgkmcnt(" #n ")" ::: "memory")
#define PG8_BAR __builtin_amdgcn_s_barrier()
#define PG8_SCHED __builtin_amdgcn_sched_barrier(0)
    Unit cur, nxt; int ui = 0;
    if (!S.next(0, cur)) return;
    f32x4 acc[2][2][4][2];
#pragma unroll
    for (int a = 0; a < 2; ++a)
#pragma unroll
        for (int b = 0; b < 2; ++b)
#pragma unroll
            for (int m = 0; m < 4; ++m)
#pragma unroll
                for (int n = 0; n < 2; ++n) acc[a][b][m][n] = (f32x4){0.f, 0.f, 0.f, 0.f};
    bf16x8 At[4][2], B0[2][2], B1[2][2];
    const char* cA = (const char*)(cur.seg ? g.A2 : g.A) + (size_t)cur.pm * tstep; const char* cB = (const char*)(cur.seg ? g.Bt2 : g.Bt) + (size_t)cur.pn * tstep;
    S.a_ready(cur);
    if constexpr (SP2) {
        PG8_STAGE(PG8_SB(0, 0), cB, voffB); PG8_STAGE(PG8_SB(0, 1), cB + hstep, voffB); PG8_STAGE(PG8_SA(0, 0), cA, voffA); PG8_STAGE(PG8_SA(0, 1), cA + hstep, voffA);
        if (wr == 1) PG8_BAR;
        PG8_WAIT_V(2); PG8_BAR;
        PG8_STAGE(PG8_SB(1, 0), cB + kstep, voffB); PG8_STAGE(PG8_SA(1, 0), cA + kstep, voffA); PG8_STAGE(PG8_SB(1, 1), cB + hstep + kstep, voffB);
        PG8_WAIT_V(6); PG8_BAR;
    } else {
        PG8_STAGE(PG8_SB(0, 0), cB, voffB); PG8_STAGE(PG8_SA(0, 0), cA, voffA); PG8_STAGE(PG8_SB(0, 1), cB + hstep, voffB); PG8_STAGE(PG8_SA(0, 1), cA + hstep, voffA);
        if (wr == 1) PG8_BAR;
        PG8_WAIT_V(4); PG8_BAR;
        PG8_STAGE(PG8_SB(1, 0), cB + kstep, voffB); PG8_STAGE(PG8_SA(1, 0), cA + kstep, voffA); PG8_STAGE(PG8_SB(1, 1), cB + hstep + kstep, voffB);
        PG8_WAIT_V(6); PG8_BAR;
    }
    for (;;) {
        const bool has_next = S.next(ui + 1, nxt);
        const char* nA = has_next ? (const char*)(nxt.seg ? g.A2 : g.A) + (size_t)nxt.pm * tstep : cA; const char* nB = has_next ? (const char*)(nxt.seg ? g.Bt2 : g.Bt) + (size_t)nxt.pn * tstep : cB;
        for (int t = 0; t < nt; t += 2) {
            const bool last = (t == nt - 2);
            const char* a1 = cA + (size_t)(t + 1) * kstep;
            const char* a2 = last ? nA : cA + (size_t)(t + 2) * kstep; const char* b2 = last ? nB : cB + (size_t)(t + 2) * kstep;
            const char* a3 = a2 + kstep; const char* b3 = b2 + kstep;
            if (last && has_next) S.a_ready(nxt);
            if constexpr (SP2) {
            PG8_LDB(B0, 0, 0); PG8_LDB(B1, 0, 1); PG8_SCHED; PG8_LDA(At, 0, 0); PG8_STAGE(PG8_SA(1, 1), a1 + hstep, voffA);
            PG8_WAIT_V(8); PG8_WAIT_L(0); PG8_BAR; PG8_MMA(0, 0, At, B0); PG8_MMA(0, 1, At, B1); PG8_BAR; PG8_SCHED;
            PG8_LDA(At, 0, 1); PG8_STAGE(PG8_SB(0, 0), b2, voffB); PG8_STAGE(PG8_SB(0, 1), b2 + hstep, voffB); PG8_STAGE(PG8_SA(0, 0), a2, voffA);
            PG8_WAIT_V(8); PG8_WAIT_L(0); PG8_BAR; PG8_MMA(1, 0, At, B0); PG8_MMA(1, 1, At, B1); PG8_BAR; PG8_SCHED;
            PG8_LDB(B0, 1, 0); PG8_LDB(B1, 1, 1); PG8_SCHED; PG8_LDA(At, 1, 0); PG8_STAGE(PG8_SA(0, 1), a2 + hstep, voffA);
            PG8_WAIT_V(8); PG8_WAIT_L(0); PG8_BAR; PG8_MMA(0, 0, At, B0); PG8_MMA(0, 1, At, B1); PG8_BAR; PG8_SCHED;
            PG8_LDA(At, 1, 1); PG8_STAGE(PG8_SB(1, 0), b3, voffB); PG8_STAGE(PG8_SB(1, 1), b3 + hstep, voffB); PG8_STAGE(PG8_SA(1, 0), a3, voffA);
            PG8_WAIT_V(8); PG8_WAIT_L(0); PG8_BAR; PG8_MMA(1, 0, At, B0); PG8_MMA(1, 1, At, B1); PG8_BAR; PG8_SCHED;
            } else {
            PG8_LDB(B0, 0, 0); PG8_SCHED; PG8_LDA(At, 0, 0); PG8_STAGE(PG8_SA(1, 1), a1 + hstep, voffA);
            PG8_WAIT_L(8); PG8_BAR; PG8_WAIT_L(0); PG8_MMA(0, 0, At, B0); PG8_BAR; PG8_SCHED;
            PG8_LDB(B1, 0, 1); PG8_STAGE(PG8_SB(0, 0), b2, voffB);
            PG8_BAR; PG8_WAIT_L(0); PG8_MMA(0, 1, At, B1); PG8_BAR;
            PG8_LDA(At, 0, 1); PG8_STAGE(PG8_SA(0, 0), a2, voffA);
            PG8_BAR; PG8_WAIT_L(0); PG8_MMA(1, 0, At, B0); PG8_BAR; PG8_SCHED;
            PG8_STAGE(PG8_SB(0, 1), b2 + hstep, voffB);
            PG8_WAIT_V(6); PG8_BAR; PG8_MMA(1, 1, At, B1); PG8_BAR;
            PG8_LDB(B0, 1, 0); PG8_SCHED; PG8_LDA(At, 1, 0); PG8_STAGE(PG8_SA(0, 1), a2 + hstep, voffA);
            PG8_WAIT_L(8); PG8_BAR; PG8_WAIT_L(0); PG8_MMA(0, 0, At, B0); PG8_BAR; PG8_SCHED;
            PG8_LDB(B1, 1, 1); PG8_STAGE(PG8_SB(1, 0), b3, voffB);
            PG8_BAR; PG8_WAIT_L(0); PG8_MMA(0, 1, At, B1); PG8_BAR;
            PG8_LDA(At, 1, 1); PG8_STAGE(PG8_SA(1, 0), a3, voffA);
            PG8_BAR; PG8_WAIT_L(0); PG8_MMA(1, 0, At, B0); PG8_BAR; PG8_SCHED;
            PG8_STAGE(PG8_SB(1, 1), b3 + hstep, voffB);
            PG8_WAIT_V(6); PG8_BAR; PG8_MMA(1, 1, At, B1); PG8_BAR;
            }
        }
        if constexpr (ALIGN_EPI) { if (wr == 0) PG8_BAR; }
        if constexpr (!Epi::AFTER_DRAIN) { E(acc, cur, wr, wc, fr, fq); S.done(cur); }
        if (!has_next) break;
        if (!(Epi::CHAIN && cur.seg == 0)) {
#pragma unroll
        for (int a = 0; a < 2; ++a)
#pragma unroll
            for (int b = 0; b < 2; ++b)
#pragma unroll
                for (int m = 0; m < 4; ++m)
#pragma unroll
                    for (int n = 0; n < 2; ++n) acc[a][b][m][n] = (f32x4){0.f, 0.f, 0.f, 0.f};
        }
        cur = nxt; cA = nA; cB = nB; ++ui;
        if constexpr (ALIGN_EPI) { if (wr == 1) PG8_BAR; }
    }
    PG8_WAIT_V(0);
    if constexpr (!ALIGN_EPI) { if (wr == 0) PG8_BAR; }
    PG8_BAR;
    if constexpr (Epi::AFTER_DRAIN) { E.fused(acc, cur, wr, wc, fr, fq, lds, wid, lane); S.done(cur); }
#undef PG8_SA
#undef PG8_SB
#undef PG8_STAGE
#undef PG8_LDA
#undef PG8_LDB
#undef PG8_MMA
#undef PG8_WAIT_V
#undef PG8_WAIT_L
#undef PG8_BAR
#undef PG8_SCHED
}
}

#define LAS __attribute__((address_space(3)))
typedef unsigned short bf16_t;
typedef float f32x4 __attribute__((ext_vector_type(4)));
typedef short bf16x8 __attribute__((ext_vector_type(8)));
typedef unsigned u32x4 __attribute__((ext_vector_type(4)));
typedef unsigned u32x2 __attribute__((ext_vector_type(2)));

constexpr int T = 32768, DM = 2048, SEQ = 4096, NBATCH = 8;
constexpr int N1 = 11520;
constexpr int DFF = 5504, NUP = 11008;
constexpr int NWAVES = 8, NTHREADS = 512;
constexpr int LDS_BYTES = 147456;
constexpr float LN_EPS = 1e-5f;
constexpr float ALPHA = 1.189207115002721f;
constexpr int NPHASE = 13;

constexpr size_t MiB = 1u << 20;
constexpr size_t WS_WIN = 1 * MiB, WS_WBNA = 46 * MiB, WS_WBML = 50 * MiB, WS_WOUT = 54 * MiB, WS_WUP = 62 * MiB, WS_WDN = 105 * MiB;
constexpr size_t WS_GATES = 127 * MiB, WS_BV = 129 * MiB, WS_AV = 130 * MiB, WS_PMV = 131 * MiB, WS_BL = 132 * MiB, WS_AM = 132 * MiB + 65536;
constexpr size_t WS_XB = 136 * MiB, WS_NAQKV = 264 * MiB, WS_MLQK = 456 * MiB, WS_MLV = 584 * MiB, WS_MLO = 648 * MiB, WS_MG = 712 * MiB;
constexpr size_t WS_QC = 136 * MiB, WS_KC = 200 * MiB;
constexpr size_t WS_HOUT = 456 * MiB, WS_YML = 584 * MiB, WS_TMP = 136 * MiB, WS_MIXED = 456 * MiB, WS_X1B = 136 * MiB;
constexpr size_t WS_BR1 = 264 * MiB, WS_BR2 = 136 * MiB;
constexpr size_t WS_EDGE = 264 * MiB, WS_ACT = 608 * MiB, WS_END = 968 * MiB;
constexpr size_t DO_SPRE = 0;
constexpr size_t DO_KCT = 0, DO_VTML = 64 * MiB, DO_VTNA = 128 * MiB, DO_YNA = 192 * MiB;

struct Params { const float* in[19]; float* out; unsigned char* ws; int ph_lo, ph_hi, flags, li; };

__device__ __forceinline__ unsigned f2bf(float f) { unsigned u = __builtin_bit_cast(unsigned, f); return (u + 0x7fffu + ((u >> 16) & 1u)) >> 16; }
__device__ __forceinline__ unsigned pk2(float lo, float hi) { unsigned r; asm("v_cvt_pk_bf16_f32 %0, %1, %2" : "=v"(r) : "v"(lo), "v"(hi)); return r; }
__device__ __forceinline__ float bflo(unsigned w) { return __builtin_bit_cast(float, w << 16); }
__device__ __forceinline__ float bfhi(unsigned w) { return __builtin_bit_cast(float, w & 0xffff0000u); }
__device__ __forceinline__ float sigmoidf_(float x) { return __builtin_amdgcn_rcpf(1.0f + __expf(-x)); }
__device__ __forceinline__ float gelu_f(float v) {
    const float av = fabsf(v), t = __builtin_amdgcn_rcpf(av * 0.2316418882f + 1.0f);
    float q = t * 0.5307027145f + (-0.7265760135f); q = q * t + 0.7107068705f; q = q * t + (-0.142248368f); q = q * t + 0.127414796f; q = q * t;
    const float e = __builtin_amdgcn_exp2f(v * v * (-0.72134752044f)), m = v * (q * e);
    return v < 0.f ? m : v - m;
}
__device__ __forceinline__ f32x4 mfma16(bf16x8 a, bf16x8 b, f32x4 c) { return __builtin_amdgcn_mfma_f32_16x16x32_bf16(a, b, c, 0, 0, 0); }
__device__ __forceinline__ bf16x8 mk8(u32x2 lo, u32x2 hi) { u32x4 w; w.x = lo.x; w.y = lo.y; w.z = hi.x; w.w = hi.y; return __builtin_bit_cast(bf16x8, w); }

__device__ __forceinline__ void store_tile_bf16(const f32x4 (&acc)[2][2][4][2], bf16_t* base, size_t ldc, int row0, int col0) {
#pragma unroll
    for (int ai = 0; ai < 2; ++ai)
#pragma unroll
        for (int m = 0; m < 4; ++m) { bf16_t* rowp = base + (size_t)(row0 + ai * 128 + m * 16) * ldc + col0;
#pragma unroll
            for (int bj = 0; bj < 2; ++bj) { const f32x4 v0 = acc[ai][bj][m][0], v1 = acc[ai][bj][m][1];
                u32x4 w; w.x = pg8::cvt_pk_bf16(v0[0], v0[1]); w.y = pg8::cvt_pk_bf16(v0[2], v0[3]); w.z = pg8::cvt_pk_bf16(v1[0], v1[1]); w.w = pg8::cvt_pk_bf16(v1[2], v1[3]);
                *(u32x4*)(rowp + bj * 128) = w; } }
}
struct EpiProj {
    static constexpr bool PERM = true, AFTER_DRAIN = false, CHAIN = false;
    bf16_t *naqkv, *mlqk, *mlv, *mlo, *mg; float* gates;
    __device__ __forceinline__ void operator()(const f32x4 (&acc)[2][2][4][2], const pg8::Unit& u, int wr, int wc, int fr, int fq) const {
        const int pn = u.pn, row0 = u.pm * 256 + wr * 64 + fr;
        if (pn == 44) {
            if (wc == 0 && fq < 2) {
#pragma unroll
                for (int ai = 0; ai < 2; ++ai)
#pragma unroll
                    for (int m = 0; m < 4; ++m) { float* gp = gates + (size_t)(row0 + ai * 128 + m * 16) * 16 + 8 * fq;
                        *(f32x4*)gp = acc[ai][0][m][0]; *(f32x4*)(gp + 4) = acc[ai][0][m][1]; }
            }
            return;
        }
        bf16_t* base; int ldc, colt;
        if (pn < 12) { base = naqkv; ldc = 3072; colt = pn * 256; }
        else if (pn < 20) { base = mlqk; ldc = 2048; colt = (pn - 12) * 256; }
        else if (pn < 24) { base = mlv; ldc = 1024; colt = (pn - 20) * 256; }
        else {
            const bool og = pn < 28; unsigned char* gq = (unsigned char*)(og ? mlo : mg); const int gld = og ? 1024 : 4096; const int col0 = (pn - (og ? 24 : 28)) * 256 + wc * 32 + 8 * fq;
#pragma unroll
            for (int ai = 0; ai < 2; ++ai)
#pragma unroll
                for (int m = 0; m < 4; ++m) { unsigned char* rowp = gq + (size_t)(row0 + ai * 128 + m * 16) * gld + col0;
#pragma unroll
                    for (int bj = 0; bj < 2; ++bj) { unsigned w2[2];
#pragma unroll
                        for (int n = 0; n < 2; ++n) { unsigned wv = 0u;
#pragma unroll
                            for (int e = 0; e < 4; ++e) { const float gsig = sigmoidf_(acc[ai][bj][m][n][e]); const float qf_ = fminf(fmaxf(__builtin_rintf(gsig * 255.0f), 1.0f), 255.0f); wv |= (unsigned)qf_ << (8 * e); }
                            w2[n] = wv; }
                        *(u32x2*)(rowp + bj * 128) = (u32x2){w2[0], w2[1]}; } }
            return;
        }
        store_tile_bf16(acc, base, (size_t)ldc, row0, colt + wc * 32 + 8 * fq);
    }
};
struct EpiPlainBf16 {
    static constexpr bool PERM = true, AFTER_DRAIN = false, CHAIN = false;
    bf16_t* O; int ldc;
    __device__ __forceinline__ void operator()(const f32x4 (&acc)[2][2][4][2], const pg8::Unit& u, int wr, int wc, int fr, int fq) const {
        store_tile_bf16(acc, O, (size_t)ldc, u.pm * 256 + wr * 64 + fr, u.pn * 256 + wc * 32 + 8 * fq);
    }
};
template <int MODE> struct EpiF32 {
    static constexpr bool PERM = true, AFTER_DRAIN = false, CHAIN = false;
    const bf16_t* mg; const float* src; float* dst; bf16_t* dstb;
    __device__ __forceinline__ void operator()(const f32x4 (&acc)[2][2][4][2], const pg8::Unit& u, int wr, int wc, int fr, int fq) const {
        const int row0 = u.pm * 256 + wr * 64 + fr, col0 = u.pn * 256 + wc * 32 + 8 * fq;
#pragma unroll
        for (int ai = 0; ai < 2; ++ai)
#pragma unroll
            for (int m = 0; m < 4; ++m) { const size_t r = (size_t)(row0 + ai * 128 + m * 16);
#pragma unroll
                for (int bj = 0; bj < 2; ++bj)
#pragma unroll
                    for (int n = 0; n < 2; ++n) { const int c = col0 + bj * 128 + n * 4; const f32x4 a = acc[ai][bj][m][n];
                        if (MODE == 0 || MODE == 1) {
                            const u32x2 gw = *(const u32x2*)(mg + r * 4096 + (MODE == 1 ? 2048 : 0) + c);
                            f32x4 gt; gt[0] = sigmoidf_(bflo(gw.x)); gt[1] = sigmoidf_(bfhi(gw.x)); gt[2] = sigmoidf_(bflo(gw.y)); gt[3] = sigmoidf_(bfhi(gw.y));
                            if (MODE == 0) { *(f32x4*)(dst + r * 2048 + c) = gt * a; }
                            else { const f32x4 t = *(const f32x4*)(src + r * 2048 + c) + gt * a; u32x2 w; w.x = pk2(t[0], t[1]); w.y = pk2(t[2], t[3]); *(u32x2*)(dstb + r * 2048 + c) = w; }
                        } else {
                            const f32x4 xv = *(const f32x4*)(src + r * 2048 + c);
                            *(f32x4*)(dst + r * 2048 + c) = xv * ALPHA + a;
                        }
                    } }
    }
};

struct EpiGlu {
    static constexpr bool PERM = true, AFTER_DRAIN = false, CHAIN = false;
    bf16_t* act; bf16_t* edge; const float* cw; const float* cb;
    __device__ __forceinline__ void operator()(const f32x4 (&acc)[2][2][4][2], const pg8::Unit& u, int wr, int wc, int fr, int fq) const {
        const int j0 = u.pn * 128 + wc * 32 + 8 * fq;
        const int lane = fq * 16 + fr, psrc = (lane & 48) | ((fr + 15) & 15), nsrc = (lane & 48) | ((fr + 1) & 15);
#pragma unroll
        for (int ai = 0; ai < 2; ++ai) {
            const int kb = u.pm * 4 + ai * 2 + wr;
            bf16_t* eb = edge + (size_t)kb * 6 * DFF + j0;
            { const bool lo = fr < 2, hi = fr >= 14;
              const f32x4 ga = lo ? acc[ai][0][0][0] : acc[ai][0][3][0], gb = lo ? acc[ai][0][0][1] : acc[ai][0][3][1];
              const f32x4 va = lo ? acc[ai][1][0][0] : acc[ai][1][3][0], vb = lo ? acc[ai][1][0][1] : acc[ai][1][3][1];
              if (lo || hi) { bf16_t* ep = eb + (size_t)(lo ? fr : fr - 12) * DFF; *(u32x4*)ep = (u32x4){pk2(ga[0], ga[1]), pk2(ga[2], ga[3]), pk2(gb[0], gb[1]), pk2(gb[2], gb[3])}; }
              if (fr == 0 || fr == 15) { bf16_t* ep = eb + (size_t)(fr == 0 ? 4 : 5) * DFF; *(u32x4*)ep = (u32x4){pk2(va[0], va[1]), pk2(va[2], va[3]), pk2(vb[0], vb[1]), pk2(vb[2], vb[3])}; } }
#pragma unroll
            for (int n = 0; n < 2; ++n) {
                const f32x4 w0 = *(const f32x4*)(cw + j0 + 4 * n), w1 = *(const f32x4*)(cw + DFF + j0 + 4 * n), w2 = *(const f32x4*)(cw + 2 * DFF + j0 + 4 * n), bs = *(const f32x4*)(cb + j0 + 4 * n);
                f32x4 o[4];
#pragma unroll
                for (int e = 0; e < 4; ++e) {
                    float t[4], sx[4];
#pragma unroll
                    for (int m = 0; m < 4; ++m) { const float gv = acc[ai][0][m][n][e]; t[m] = __shfl(gv, psrc); sx[m] = __shfl(gv, nsrc); }
#pragma unroll
                    for (int m = 0; m < 4; ++m) { const float gv = acc[ai][0][m][n][e];
                        const float prev = (fr == 0) ? (m > 0 ? t[m > 0 ? m - 1 : 0] : 0.f) : t[m];
                        const float next = (fr == 15) ? (m < 3 ? sx[m < 3 ? m + 1 : 3] : 0.f) : sx[m];
                        const float y = w0[e] * prev + w1[e] * gv + w2[e] * next + bs[e];
                        o[m][e] = gelu_f(y) * acc[ai][1][m][n][e]; } }
#pragma unroll
                for (int m = 0; m < 4; ++m) { const int rho = 16 * m + fr;
                    if (rho != 0 && rho != 63) { u32x2 wv; wv.x = pk2(o[m][0], o[m][1]); wv.y = pk2(o[m][2], o[m][3]);
                        *(u32x2*)(act + (size_t)(kb * 64 + rho) * DFF + j0 + 4 * n) = wv; } }
            }
        }
    }
};

struct MergeOrder { pg8::StaticOrder base;
    __device__ bool next(int i, pg8::Unit& u) const { if (!base.next(i >> 1, u)) return false; u.seg = i & 1; return true; }
    __device__ __forceinline__ void a_ready(const pg8::Unit&) const {}
    __device__ __forceinline__ void done(const pg8::Unit&) const {}
};
struct EpiMerge {
    static constexpr bool PERM = true, AFTER_DRAIN = false, CHAIN = true;
    const bf16_t* mg; bf16_t* dstb;
    __device__ __forceinline__ void operator()(f32x4 (&acc)[2][2][4][2], const pg8::Unit& u, int wr, int wc, int fr, int fq) const {
        const int row0 = u.pm * 256 + wr * 64 + fr, col0 = u.pn * 256 + wc * 32 + 8 * fq;
#pragma unroll
        for (int ai = 0; ai < 2; ++ai)
#pragma unroll
            for (int m = 0; m < 4; ++m) { const size_t r = (size_t)(row0 + ai * 128 + m * 16);
#pragma unroll
                for (int bj = 0; bj < 2; ++bj) { const int c = col0 + bj * 128;
                    const unsigned char* gq = (const unsigned char*)mg + r * 4096 + c;
                    const u32x2 gm = *(const u32x2*)(gq + 2048);
                    float qm[8];
#pragma unroll
                    for (int i = 0; i < 8; ++i) qm[i] = (float)((gm[i >> 2] >> (8 * (i & 3))) & 0xffu);
                    if (u.seg == 0) {
                        const u32x2 gn = *(const u32x2*)gq;
#pragma unroll
                        for (int n = 0; n < 2; ++n)
#pragma unroll
                            for (int e = 0; e < 4; ++e) { const float qn = (float)((gn[n] >> (8 * e)) & 0xffu); acc[ai][bj][m][n][e] *= qn * __builtin_amdgcn_rcpf(qm[4 * n + e]); }
                    } else {
                        float o[8];
#pragma unroll
                        for (int n = 0; n < 2; ++n)
#pragma unroll
                            for (int e = 0; e < 4; ++e) o[4 * n + e] = acc[ai][bj][m][n][e] * (qm[4 * n + e] * (1.0f / 255.0f));
                        u32x4 w; w.x = pk2(o[0], o[1]); w.y = pk2(o[2], o[3]); w.z = pk2(o[4], o[5]); w.w = pk2(o[6], o[7]);
                        *(u32x4*)(dstb + r * 2048 + c) = w;
                    } } }
    }
};

__device__ __forceinline__ float wave_sum(float v) {
#pragma unroll
    for (int o = 1; o < 64; o <<= 1) v += __shfl_xor(v, o);
    return v;
}
__device__ __forceinline__ void transpose_item(const float* W, int ldw, int src0, int nvalid, int k0, int K, bf16_t* WT, int drow0, float* scr, int lane) {
    const int n_ = lane & 31;
    float tv[32];
#pragma unroll
    for (int i = 0; i < 32; ++i) { const int kk = 2 * i + (lane >> 5); tv[i] = (n_ < nvalid) ? W[(size_t)(k0 + kk) * ldw + src0 + n_] : 0.f; }
#pragma unroll
    for (int i = 0; i < 32; ++i) { const int kk = 2 * i + (lane >> 5); scr[kk * 33 + n_] = tv[i]; }
    __builtin_amdgcn_s_waitcnt(0); asm volatile("" ::: "memory");
    const int c = lane & 7;
#pragma unroll
    for (int j = 0; j < 4; ++j) { const int n = (lane >> 3) + 8 * j; const float* s = scr + (8 * c) * 33 + n;
        u32x4 o; o.x = pk2(s[0 * 33], s[1 * 33]); o.y = pk2(s[2 * 33], s[3 * 33]); o.z = pk2(s[4 * 33], s[5 * 33]); o.w = pk2(s[6 * 33], s[7 * 33]);
        *(u32x4*)(WT + (size_t)(drow0 + n) * K + k0 + 8 * c) = o; }
    __builtin_amdgcn_s_waitcnt(0); asm volatile("" ::: "memory");
}

__device__ __forceinline__ void phase_prologue(const Params& p, unsigned char* lds) {
    const int tid = threadIdx.x, lane = tid & 63, wave = tid >> 6;
    const int gw = blockIdx.x * NWAVES + wave, NGW = gridDim.x * NWAVES;
    float* scr = (float*)(lds + wave * 16384);
    unsigned char* ws = p.ws;
    constexpr int I_IN = 32 * 360, I_BN = 16 * 64, I_OUT = 32 * 64, I_UP = 32 * 344, I_DN = 86 * 64;
    constexpr int NITEMS = I_IN + 2 * I_BN + I_OUT + I_UP + I_DN;
    for (int it = gw; it < NITEMS; it += NGW) {
        int r = it;
        if (r < I_IN) { const int kb = r / 360, nb = r % 360, n0 = nb * 32; int src0, nv;
            if (n0 < 7168) { src0 = n0; nv = 32; } else if (n0 < 11264) { src0 = n0 + 16; nv = 32; } else if (n0 == 11264) { src0 = 7168; nv = 16; } else { src0 = 0; nv = 0; }
            transpose_item(p.in[1], 11280, src0, nv, kb * 64, 2048, (bf16_t*)(ws + WS_WIN), n0, scr, lane); continue; }
        r -= I_IN;
        if (r < I_BN) { const int kb = r / 64, nb = r % 64; transpose_item(p.in[8], 2048, nb * 32, 32, kb * 64, 1024, (bf16_t*)(ws + WS_WBNA), nb * 32, scr, lane); continue; }
        r -= I_BN;
        if (r < I_BN) { const int kb = r / 64, nb = r % 64; transpose_item(p.in[9], 2048, nb * 32, 32, kb * 64, 1024, (bf16_t*)(ws + WS_WBML), nb * 32, scr, lane); continue; }
        r -= I_BN;
        if (r < I_OUT) { const int kb = r / 64, nb = r % 64; transpose_item(p.in[10], 2048, nb * 32, 32, kb * 64, 2048, (bf16_t*)(ws + WS_WOUT), nb * 32, scr, lane); continue; }
        r -= I_OUT;
        if (r < I_UP) { const int kb = r / 344, nb = r % 344, n0 = nb * 32, pt = n0 >> 8, l0 = n0 & 255;
            const int src0 = (l0 < 128) ? pt * 128 + l0 : DFF + pt * 128 + (l0 - 128);
            transpose_item(p.in[13], NUP, src0, 32, kb * 64, 2048, (bf16_t*)(ws + WS_WUP), n0, scr, lane); continue; }
        r -= I_UP;
        { const int kb = r / 64, nb = r % 64; transpose_item(p.in[16], 2048, nb * 32, 32, kb * 64, DFF, (bf16_t*)(ws + WS_WDN), nb * 32, scr, lane); }
    }
    const float* x = p.in[0]; bf16_t* xb = (bf16_t*)(ws + WS_XB);
    const size_t n8 = (size_t)T * DM / 8, stride = (size_t)gridDim.x * NTHREADS;
    for (size_t i0 = (size_t)blockIdx.x * NTHREADS + tid; i0 < n8; i0 += 4 * stride) {
        f32x4 a[4], b[4];
#pragma unroll
        for (int u = 0; u < 4; ++u) { const size_t i = min(i0 + u * stride, n8 - 1); a[u] = __builtin_nontemporal_load((const f32x4*)(x + i * 8)); b[u] = __builtin_nontemporal_load((const f32x4*)(x + i * 8 + 4)); }
#pragma unroll
        for (int u = 0; u < 4; ++u) { const size_t i = i0 + u * stride; if (i >= n8) continue;
            u32x4 w; w.x = pk2(a[u][0], a[u][1]); w.y = pk2(a[u][2], a[u][3]); w.z = pk2(b[u][0], b[u][1]); w.w = pk2(b[u][2], b[u][3]);
            *(u32x4*)(xb + i * 8) = w; }
    }
}

__device__ __forceinline__ void phase_prep(const Params& p, unsigned char* lds) {
    const int tid = threadIdx.x, lane = tid & 63, wave = tid >> 6;
    unsigned char* ws = p.ws; unsigned char* dout = (unsigned char*)p.out;
    const bf16_t* mlqk = (const bf16_t*)(ws + WS_MLQK); const bf16_t* mlv = (const bf16_t*)(ws + WS_MLV); const bf16_t* naqkv = (const bf16_t*)(ws + WS_NAQKV);
    bf16_t* Qc = (bf16_t*)(ws + WS_QC); bf16_t* Kc = (bf16_t*)(ws + WS_KC);
    bf16_t* KcT = (bf16_t*)(dout + DO_KCT); bf16_t* VTml = (bf16_t*)(dout + DO_VTML); bf16_t* VTna = (bf16_t*)(dout + DO_VTNA);
    const float* cw = p.in[3]; const float* cb = p.in[4];
    unsigned short* tile = (unsigned short*)lds;
    const int tl = tid >> 3, c8 = tid & 7;
    {
        for (int item = blockIdx.x; item < 1024; item += gridDim.x) {
            const int ci = item & 31, h = (item >> 5) & 3, b = item >> 7;
            const size_t tb = (size_t)b * 4096 + 128 * ci;
#pragma unroll 1
            for (int bt = 0; bt < 4; ++bt) {
                u32x4 cur[4], prv[4], nxt[4];
#pragma unroll
                for (int u = 0; u < 4; ++u) { const int i = bt * 4 + u, L = i * 512 + tid, s_ = (L >> 5) & 127, ch = L & 31, cc = (i >> 3) * 1024 + h * 256 + ch * 8, sq = 128 * ci + s_;
                    const bf16_t* sp = mlqk + (tb + s_) * 2048 + cc;
                    cur[u] = *(const u32x4*)sp; prv[u] = (u32x4){0u, 0u, 0u, 0u}; nxt[u] = (u32x4){0u, 0u, 0u, 0u};
                    if (sq > 0) prv[u] = *(const u32x4*)(sp - 2048);
                    if (sq < 4095) nxt[u] = *(const u32x4*)(sp + 2048); }
#pragma unroll
                for (int u = 0; u < 4; ++u) { const int i = bt * 4 + u, L = i * 512 + tid, s_ = (L >> 5) & 127, ch = L & 31, isk = i >> 3, cc = isk * 1024 + h * 256 + ch * 8;
                    float w0[8], w1[8], w2[8], bs[8];
#pragma unroll
                    for (int q = 0; q < 2; ++q) { const f32x4 a0 = *(const f32x4*)(cw + cc + 4 * q), a1 = *(const f32x4*)(cw + 2048 + cc + 4 * q), a2 = *(const f32x4*)(cw + 4096 + cc + 4 * q), a3 = *(const f32x4*)(cb + cc + 4 * q);
#pragma unroll
                        for (int e = 0; e < 4; ++e) { w0[4 * q + e] = a0[e]; w1[4 * q + e] = a1[e]; w2[4 * q + e] = a2[e]; bs[4 * q + e] = a3[e]; } }
                    const float sc = isk ? 0.0625f : 1.0f;
                    float o[8];
#pragma unroll
                    for (int k = 0; k < 4; ++k) {
                        const float yl = w0[2 * k] * bflo(prv[u][k]) + w1[2 * k] * bflo(cur[u][k]) + w2[2 * k] * bflo(nxt[u][k]) + bs[2 * k];
                        const float yh = w0[2 * k + 1] * bfhi(prv[u][k]) + w1[2 * k + 1] * bfhi(cur[u][k]) + w2[2 * k + 1] * bfhi(nxt[u][k]) + bs[2 * k + 1];
                        o[2 * k] = yl * sigmoidf_(yl) * sc; o[2 * k + 1] = yh * sigmoidf_(yh) * sc; }
                    u32x4 wv; wv.x = pk2(o[0], o[1]); wv.y = pk2(o[2], o[3]); wv.z = pk2(o[4], o[5]); wv.w = pk2(o[6], o[7]);
                    *(u32x4*)((isk ? Kc : Qc) + (tb + s_) * 1024 + h * 256 + ch * 8) = wv;
                    }
            }
        }
    }
    const float* gates = (const float*)(ws + WS_GATES);
    float* Bv = (float*)(ws + WS_BV); float* Av = (float*)(ws + WS_AV); float* PMv = (float*)(ws + WS_PMV); float* BL = (float*)(ws + WS_BL); float* AM = (float*)(ws + WS_AM);
    const float* igb = p.in[5]; const float* fgb = p.in[6];
    for (int wi = blockIdx.x * NWAVES + wave; wi < 2048; wi += gridDim.x * NWAVES) {
        const int seq = wi >> 5, c = wi & 31, g = seq >> 5, b = (seq >> 2) & 7, h = seq & 3;
        const int sb = g ? 4096 - 128 * (c + 1) : 128 * c;
        const int p0 = 2 * lane, p1 = p0 + 1, u0 = g ? 127 - p0 : p0, u1 = g ? 127 - p1 : p1;
        const size_t t0 = (size_t)b * 4096 + sb + u0, t1 = (size_t)b * 4096 + sb + u1;
        const float fb = fgb[g * 4 + h], ib = igb[g * 4 + h];
        const float f0 = gates[t0 * 16 + 8 + g * 4 + h] + fb, f1 = gates[t1 * 16 + 8 + g * 4 + h] + fb;
        const float i0 = gates[t0 * 16 + g * 4 + h] + ib, i1 = gates[t1 * 16 + g * 4 + h] + ib;
        const float lf0 = fminf(f0, 0.f) - log1pf(expf(-fabsf(f0))), lf1 = fminf(f1, 0.f) - log1pf(expf(-fabsf(f1)));
        const float s1 = lf0 + lf1;
        float inc = s1;
#pragma unroll
        for (int o = 1; o < 64; o <<= 1) { const float t = __shfl_up(inc, o); if (lane >= o) inc += t; }
        const float ex = inc - s1;
        const float b0 = ex + lf0, b1 = ex + s1;
        const float a0 = i0 - b0, a1 = i1 - b1;
        const float q1 = fmaxf(a0, a1);
        float mi = q1;
#pragma unroll
        for (int o = 1; o < 64; o <<= 1) { const float t = __shfl_up(mi, o); if (lane >= o) mi = fmaxf(mi, t); }
        float exm = __shfl_up(mi, 1); if (lane == 0) exm = -3.0e38f;
        const float pm0 = fmaxf(exm, a0), pm1 = fmaxf(exm, q1);
        const float blast = __shfl(b1, 63), amax = __shfl(mi, 63);
        const size_t so = (size_t)seq * 4096 + sb;
        Bv[so + u0] = b0; Bv[so + u1] = b1; Av[so + u0] = a0; Av[so + u1] = a1; PMv[so + u0] = pm0; PMv[so + u1] = pm1;
        if (lane == 0) { BL[seq * 32 + c] = blast; AM[seq * 32 + c] = amax; }
    }
}

__device__ __forceinline__ void scan_item(const Params& p, int item, unsigned char* lds) {
    const int tid = threadIdx.x, lane = tid & 63, w = tid >> 6, fr = lane & 15, fq = lane >> 4;
    const int seq = item >> 2, es = item & 3, g = seq >> 5, b = (seq >> 2) & 7, h = seq & 3;
    unsigned char* ws = p.ws; unsigned char* dout = (unsigned char*)p.out;
    const bf16_t* Qc = (const bf16_t*)(ws + WS_QC); const bf16_t* Kc = (const bf16_t*)(ws + WS_KC);
    const bf16_t* KcT = (const bf16_t*)(dout + DO_KCT); const bf16_t* VTml = (const bf16_t*)(dout + DO_VTML);
    const float* Bv = (const float*)(ws + WS_BV); const float* Av = (const float*)(ws + WS_AV); const float* PMv = (const float*)(ws + WS_PMV);
    const float* BL = (const float*)(ws + WS_BL); const float* AM = (const float*)(ws + WS_AM);
    bf16_t* Hout = (bf16_t*)(ws + WS_HOUT);
    unsigned short* Cs = (unsigned short*)lds;
    float* mst = (float*)(lds + 43008); float* mnw = mst + 32; float* bls = mst + 64;
    float* SC = (float*)(lds + 43520);
    unsigned char* Ks = lds + 47104;
    unsigned char* Vs = lds + 112640;
    for (int i = tid; i < 80 * 264 / 2; i += NTHREADS) ((unsigned*)Cs)[i] = 0u;
    if (tid == 0) { float m = -1.0e30f;
        for (int c = 0; c < 32; ++c) { const float bl = BL[seq * 32 + c], am = AM[seq * 32 + c]; mst[c] = m; bls[c] = bl; const float mn = fmaxf(bl + m, bl + am); mnw[c] = mn; m = mn; } }
    f32x4 stC[2][5];
#pragma unroll
    for (int dd = 0; dd < 2; ++dd)
#pragma unroll
        for (int et = 0; et < 5; ++et) stC[dd][et] = (f32x4){0.f, 0.f, 0.f, 0.f};
    const u32x4 ones4 = (fr == 0) ? (u32x4){0x3f803f80u, 0x3f803f80u, 0x3f803f80u, 0x3f803f80u} : (u32x4){0u, 0u, 0u, 0u};
    const bf16x8 onesf = __builtin_bit_cast(bf16x8, ones4);
    const size_t seqoff = (size_t)seq * 4096;
    const int ut = 16 * w + fr;
    const int krow0 = tid >> 5, kch = tid & 31, vs0 = tid >> 3, vc16 = tid & 7;
    const bf16_t* kU = Kc + (size_t)b * 4096 * 1024 + h * 256; const unsigned kl = krow0 * 1024 + kch * 8;
    const bf16_t* vU = (const bf16_t*)(ws + WS_MLV) + (size_t)b * 4096 * 1024 + h * 256 + es * 64; const unsigned vl = vs0 * 1024 + vc16 * 8;
    const float* sU = Av + seqoff; const int sl_ = (tid < 128 ? 0 : (tid < 256 ? 262144 : -262144)) + (tid & 127);
    const bf16_t* qU = Qc + (size_t)b * 4096 * 1024 + h * 256; const unsigned ql = ut * 1024 + fq * 8;
    bf16_t* hU = Hout + ((size_t)g * T + (size_t)b * 4096) * 1024 + h * 256 + es * 64; const unsigned hl = ut * 1024 + 4 * fq;
    const int koff = fr * 512, kx0 = ((0 + fq) ^ fr) << 4;
    u32x4 kpre[8], vpre[2]; float spre = 0.f;
    bf16x8 qf[8];
    {   const int sb0 = g ? 4096 - 128 : 0;
#pragma unroll
        for (int i = 0; i < 8; ++i) kpre[i] = *(const u32x4*)(kU + (size_t)(sb0 * 1024 + i * 16384 + kl));
#pragma unroll
        for (int i = 0; i < 2; ++i) vpre[i] = *(const u32x4*)(vU + (size_t)((sb0 + 64 * i) * 1024 + vl));
        if (tid < 384) spre = sU[sb0 + sl_];
        const bf16_t* qrow = qU + (size_t)(sb0 * 1024 + ql);
#pragma unroll
        for (int ks = 0; ks < 8; ++ks) qf[ks] = *(const bf16x8*)(qrow + ks * 32);
    }
#define SCAN_SB() __builtin_amdgcn_sched_barrier(0)
    for (int c = 0; c < 32; ++c) {
        const int sb = g ? 4096 - 128 * (c + 1) : 128 * c;
        const int sbn = g ? 4096 - 128 * (c + 2) : 128 * (c + 1);
        unsigned char* Vc = Vs + (c & 1) * 16384;
        float* SCc = SC + (c & 1) * 384;
#pragma unroll
        for (int i = 0; i < 8; ++i) { const int row = i * 16 + krow0; *(u32x4*)(Ks + row * 512 + ((kch ^ (row & 15)) << 4)) = kpre[i]; }
        int vs_v = vs0, vc_v = vc16; asm volatile("" : "+v"(vs_v), "+v"(vc_v));
#pragma unroll
        for (int i = 0; i < 2; ++i) { const int s_ = 64 * i + vs_v, k2_ = s_ >> 5, sl_ = s_ & 31;
            const int pos_ = (sl_ < 16) ? (sl_ >> 2) * 8 + (sl_ & 3) : ((sl_ - 16) >> 2) * 8 + 4 + (sl_ & 3);
            const int ch_ = k2_ * 4 + (pos_ >> 3), by_ = (pos_ & 7) * 2;
#pragma unroll
            for (int q = 0; q < 8; ++q) { const int e = 8 * vc_v + q; const unsigned wd = vpre[i][q >> 1];
                *(unsigned short*)(Vc + e * 256 + ((ch_ ^ (e & 15)) << 4) + by_) = (unsigned short)((q & 1) ? (wd >> 16) : (wd & 0xffffu)); } }
        if (tid < 384) SCc[tid] = spre;
        __syncthreads();
        const float m_st = mst[c], m_nw = mnw[c], bl = bls[c];
        const float pm_t = SCc[128 + ut], b_t = SCc[256 + ut];
        const float M_t = fmaxf(pm_t, m_st);
        const float winter = __expf(m_st - M_t), eclamp = __expf(-(b_t + M_t));
        bf16x8 pf[4];
        {
            bf16x8 kf[2][2]; f32x4 accp = (f32x4){0.f, 0.f, 0.f, 0.f}; float sg[8];
#pragma unroll
            for (int ks = 0; ks < 2; ++ks) kf[0][ks] = *(const bf16x8*)(Ks + koff + (((ks * 4 + fq) ^ fr) << 4));
#pragma unroll
            for (int st = 0; st < 8; ++st) {
                f32x4 a = (f32x4){0.f, 0.f, 0.f, 0.f};
#pragma unroll
                for (int gq = 0; gq < 4; ++gq) { const int gi = st * 4 + gq;
                    if (gi < 31) { const int st2 = (gi + 1) >> 2, g2 = (gi + 1) & 3;
#pragma unroll
                        for (int ks = 0; ks < 2; ++ks) kf[(gi + 1) & 1][ks] = *(const bf16x8*)(Ks + st2 * 8192 + koff + ((((2 * g2 + ks) * 4 + fq) ^ fr) << 4)); }
                    SCAN_SB();
#pragma unroll
                    for (int ks = 0; ks < 2; ++ks) a = mfma16(kf[gi & 1][ks], qf[2 * gq + ks], a);
                    SCAN_SB();
                }
                if (st > 0) {
                    const int sp = st - 1; const f32x4 av_ = *(const f32x4*)(SCc + 16 * sp + 4 * fq);
#pragma unroll
                    for (int j = 0; j < 4; ++j) { const int us = 16 * sp + 4 * fq + j; const bool ok = g ? (us >= ut) : (us <= ut);
                        const float dwv = ok ? __expf(av_[j] - M_t) : 0.f; sg[4 * (sp & 1) + j] = accp[j] * dwv; }
                    if (sp & 1) { u32x4 wv; wv.x = pk2(sg[0], sg[1]); wv.y = pk2(sg[2], sg[3]); wv.z = pk2(sg[4], sg[5]); wv.w = pk2(sg[6], sg[7]); pf[sp >> 1] = __builtin_bit_cast(bf16x8, wv); }
                }
                accp = a;
            }
            const f32x4 av7 = *(const f32x4*)(SCc + 16 * 7 + 4 * fq);
#pragma unroll
            for (int j = 0; j < 4; ++j) { const int us = 16 * 7 + 4 * fq + j; const bool ok = g ? (us >= ut) : (us <= ut);
                const float dwv = ok ? __expf(av7[j] - M_t) : 0.f; sg[4 + j] = accp[j] * dwv; }
            { u32x4 wv; wv.x = pk2(sg[0], sg[1]); wv.y = pk2(sg[2], sg[3]); wv.z = pk2(sg[4], sg[5]); wv.w = pk2(sg[6], sg[7]); pf[3] = __builtin_bit_cast(bf16x8, wv); }
        }
        if (c + 1 < 32) {
#pragma unroll
            for (int i = 0; i < 8; ++i) kpre[i] = *(const u32x4*)(kU + (size_t)(sbn * 1024 + i * 16384 + kl));
#pragma unroll
            for (int i = 0; i < 2; ++i) vpre[i] = *(const u32x4*)(vU + (size_t)((sbn + 64 * i) * 1024 + vl));
            if (tid < 384) spre = sU[sbn + sl_];
        }
        bf16_t* hp = hU + (size_t)(sb * 1024 + hl);
        float rden = 0.f;
        {
            bf16x8 cf[8], vf[4];
#pragma unroll
            for (int ks = 0; ks < 8; ++ks) cf[ks] = *(const bf16x8*)(Cs + (64 + fr) * 264 + ks * 32 + fq * 8);
#pragma unroll
            for (int ei = 0; ei < 5; ++ei) { const int et = (ei == 0) ? 4 : ei - 1;
                if (et < 4) {
#pragma unroll
                    for (int k2 = 0; k2 < 4; ++k2) vf[k2] = *(const bf16x8*)(Vc + (16 * et + fr) * 256 + (((k2 * 4 + fq) ^ fr) << 4));
                }
                SCAN_SB();
                f32x4 a = (f32x4){0.f, 0.f, 0.f, 0.f};
#pragma unroll
                for (int ks = 0; ks < 8; ++ks) a = mfma16(cf[ks], qf[ks], a);
                SCAN_SB();
                if (ei < 4) {
#pragma unroll
                    for (int ks = 0; ks < 8; ++ks) cf[ks] = *(const bf16x8*)(Cs + (16 * ei + fr) * 264 + ks * 32 + fq * 8);
                }
                a = a * winter;
#pragma unroll
                for (int k2 = 0; k2 < 4; ++k2) a = mfma16(et < 4 ? vf[k2] : onesf, pf[k2], a);
                if (et == 4) { const float den = __shfl(a[0], fr); rden = 1.0f / fmaxf(fabsf(den), eclamp); }
                else { const f32x4 v = a * rden; u32x2 wv; wv.x = pk2(v[0], v[1]); wv.y = pk2(v[2], v[3]); *(u32x2*)(hp + 16 * et) = wv; } }
        }
        u32x2 ktr[2][4][2];
#pragma unroll
        for (int dd = 0; dd < 2; ++dd)
#pragma unroll
            for (int k2 = 0; k2 < 4; ++k2)
#pragma unroll
                for (int hf = 0; hf < 2; ++hf) { const int row = 32 * k2 + 16 * hf + 4 * fq + (fr >> 2), ch = 4 * w + 2 * dd + ((fr & 3) >> 1);
                    typedef short v4i16_t __attribute__((ext_vector_type(4)));
                    const v4i16_t tv = __builtin_amdgcn_ds_read_tr16_b64_v4i16((LAS v4i16_t*)(LAS unsigned char*)(Ks + row * 512 + ((ch ^ (row & 15)) << 4) + 8 * (fr & 1)));
                    ktr[dd][k2][hf] = __builtin_bit_cast(u32x2, tv); }
        __syncthreads();
        const float decay = __expf(bl + m_st - m_nw);
#pragma unroll
        for (int dd = 0; dd < 2; ++dd)
#pragma unroll
            for (int et = 0; et < 5; ++et) stC[dd][et] = stC[dd][et] * decay;
        {
            bf16x8 vf[4]; f32x4 avv[2];
#pragma unroll
            for (int k2 = 0; k2 < 4; ++k2) {
#pragma unroll
                for (int et = 0; et < 4; ++et) vf[et] = *(const bf16x8*)(Vc + (16 * et + fr) * 256 + (((k2 * 4 + fq) ^ fr) << 4));
                avv[0] = *(const f32x4*)(SCc + 32 * k2 + 4 * fq); avv[1] = *(const f32x4*)(SCc + 32 * k2 + 16 + 4 * fq);
                float wsv[8];
#pragma unroll
                for (int hf = 0; hf < 2; ++hf)
#pragma unroll
                    for (int j = 0; j < 4; ++j) wsv[4 * hf + j] = __expf(bl + avv[hf][j] - m_nw);
                bf16x8 kt[2];
#pragma unroll
                for (int dd = 0; dd < 2; ++dd) { const u32x2 lo = ktr[dd][k2][0], hi = ktr[dd][k2][1];
                    u32x4 wv; wv.x = pk2(bflo(lo.x) * wsv[0], bfhi(lo.x) * wsv[1]); wv.y = pk2(bflo(lo.y) * wsv[2], bfhi(lo.y) * wsv[3]);
                    wv.z = pk2(bflo(hi.x) * wsv[4], bfhi(hi.x) * wsv[5]); wv.w = pk2(bflo(hi.y) * wsv[6], bfhi(hi.y) * wsv[7]); kt[dd] = __builtin_bit_cast(bf16x8, wv); }
#pragma unroll
                for (int et = 0; et < 5; ++et) { const bf16x8 vv = et < 4 ? vf[et] : onesf;
                    stC[0][et] = mfma16(vv, kt[0], stC[0][et]); stC[1][et] = mfma16(vv, kt[1], stC[1][et]); }
            }
        }
        if (c + 1 < 32) { const bf16_t* qrow = qU + (size_t)(sbn * 1024 + ql);
#pragma unroll
            for (int ks = 0; ks < 8; ++ks) qf[ks] = *(const bf16x8*)(qrow + ks * 32); }
#pragma unroll
        for (int dd = 0; dd < 2; ++dd)
#pragma unroll
            for (int et = 0; et < 5; ++et)
#pragma unroll
                for (int j = 0; j < 4; j += 2) { const unsigned pw = pk2(stC[dd][et][j], stC[dd][et][j + 1]);
                    Cs[(16 * et + 4 * fq + j) * 264 + 16 * (2 * w + dd) + fr] = (unsigned short)(pw & 0xffffu); Cs[(16 * et + 4 * fq + j + 1) * 264 + 16 * (2 * w + dd) + fr] = (unsigned short)(pw >> 16); }
    }
#undef SCAN_SB
    __syncthreads();
}

__device__ __forceinline__ void na_item(const Params& p, int b, int hd, int r, int j, int lane, const float* rpl, const unsigned char* Vl) {
    const int fr = lane & 15, fq = lane >> 4;
    unsigned char* ws = p.ws; unsigned char* dout = (unsigned char*)p.out;
    const bf16_t* naqkv = (const bf16_t*)(ws + WS_NAQKV); bf16_t* yna = (bf16_t*)(dout + DO_YNA);
    const float* rp = rpl + hd * (15 * 31);
    const int rs = min(max(r - 4, 0), 56), kstart = min(max(16 * j - 8, 0), 32);
    const int qc = 16 * j + fr, wstart = min(max(qc - 8, 0), 48);
    const size_t tokq = (size_t)b * 4096 + r * 64 + qc;
    const bf16_t* qp = naqkv + tokq * 3072 + hd * 64 + fq * 8;
    const bf16x8 q0 = *(const bf16x8*)qp, q1 = *(const bf16x8*)(qp + 32);
    bf16x8 kfr[3][8];
    const bf16_t* kU = naqkv + ((size_t)b * 4096 + rs * 64 + kstart) * 3072 + 1024 + hd * 64; const unsigned kl = fr * 3072 + fq * 8;
#define NA_LOADK(buf, grp) do { _Pragma("unroll") for (int q_ = 0; q_ < 4; ++q_) { const int mt_ = 4 * (grp) + q_; const bf16_t* kp_ = kU + (size_t)(((mt_ >> 1) * 64 + (mt_ & 1) * 16) * 3072 + kl); \
        kfr[buf][2 * q_] = *(const bf16x8*)kp_; kfr[buf][2 * q_ + 1] = *(const bf16x8*)(kp_ + 32); } } while (0)
    NA_LOADK(0, 0); NA_LOADK(1, 1);
    __builtin_amdgcn_sched_barrier(0);
    f32x4 accS[16];
#pragma unroll
    for (int grp = 0; grp < 4; ++grp) {
        if (grp + 2 < 4) NA_LOADK((grp + 2) % 3, grp + 2);
        __builtin_amdgcn_sched_barrier(0);
#pragma unroll
        for (int q = 0; q < 4; ++q) { f32x4 a = (f32x4){0.f, 0.f, 0.f, 0.f}; a = mfma16(kfr[grp % 3][2 * q], q0, a); a = mfma16(kfr[grp % 3][2 * q + 1], q1, a); accS[4 * grp + q] = a; }
        __builtin_amdgcn_sched_barrier(0);
    }
#undef NA_LOADK
    float mx = -1.0e30f;
#pragma unroll
    for (int mt = 0; mt < 16; ++mt)
#pragma unroll
        for (int jj = 0; jj < 4; ++jj) { const int kcol = kstart + (mt & 1) * 16 + 4 * fq + jj; const bool valid = (kcol >= wstart) && (kcol < wstart + 16);
            const int dc = min(max(kcol - qc + 15, 0), 30), dr = rs + (mt >> 1) - r + 7;
            const float sc = valid ? accS[mt][jj] * 0.125f + rp[dr * 31 + dc] : -1.0e30f; accS[mt][jj] = sc; mx = fmaxf(mx, sc); }
    mx = fmaxf(mx, __shfl_xor(mx, 16)); mx = fmaxf(mx, __shfl_xor(mx, 32));
    float sum = 0.f;
    bf16x8 pf[8];
#pragma unroll
    for (int ks = 0; ks < 8; ++ks) { float e[8];
#pragma unroll
        for (int i = 0; i < 8; ++i) { e[i] = __expf(accS[2 * ks + (i >> 2)][i & 3] - mx); sum += e[i]; }
        u32x4 wv; wv.x = pk2(e[0], e[1]); wv.y = pk2(e[2], e[3]); wv.z = pk2(e[4], e[5]); wv.w = pk2(e[6], e[7]); pf[ks] = __builtin_bit_cast(bf16x8, wv); }
    sum += __shfl_xor(sum, 16); sum += __shfl_xor(sum, 32);
    const float rsum = 1.0f / sum;
    const int ca = (((kstart >> 2) + fq) ^ fr) << 3, cb = (((kstart >> 2) + 4 + fq) ^ fr) << 3;
    const int s0 = rs % 11;
#pragma unroll
    for (int dt = 0; dt < 4; ++dt) { f32x4 a = (f32x4){0.f, 0.f, 0.f, 0.f};
        u32x2 va[8], vb[8];
#pragma unroll
        for (int ks = 0; ks < 8; ++ks) { int sl = s0 + ks; sl = (sl >= 11) ? sl - 11 : sl; const unsigned char* vp = Vl + sl * 8192 + (16 * dt + fr) * 128;
            va[ks] = *(const u32x2*)(vp + ca); vb[ks] = *(const u32x2*)(vp + cb); }
#pragma unroll
        for (int ks = 0; ks < 8; ++ks) a = mfma16(mk8(va[ks], vb[ks]), pf[ks], a);
        a = a * rsum; u32x2 wv; wv.x = pk2(a[0], a[1]); wv.y = pk2(a[2], a[3]);
        *(u32x2*)(yna + tokq * 1024 + hd * 64 + 16 * dt + 4 * fq) = wv; }
}
__device__ __forceinline__ void na_wg_item(const Params& p, int wgi, unsigned char* lds, const float* rpl) {
    const int tid = threadIdx.x, lane = tid & 63, wave = tid >> 6;
    const int b = wgi >> 5, hd = (wgi >> 1) & 15, r0 = (wgi & 1) * 32;
    unsigned char* Vl = lds + 32768;
    const bf16_t* vU = (const bf16_t*)(p.ws + WS_NAQKV) + (size_t)b * 4096 * 3072 + 2048 + hd * 64;
    const int col = tid >> 3, c16 = tid & 7;
    const unsigned vl = col * 3072 + c16 * 8;
#define NA_HI(it) (min(max(r0 + 2 * min((it), 15) + 1 - 4, 0), 56) + 8)
#define NA_PUT(row, v) do { unsigned char* rp_ = Vl + ((row) % 11) * 8192 + (col & 3) * 2; _Pragma("unroll") for (int i_ = 0; i_ < 8; ++i_) { const int d_ = 8 * c16 + i_; const unsigned wd_ = (v)[i_ >> 1]; \
        *(unsigned short*)(rp_ + d_ * 128 + (((col >> 2) ^ (d_ & 15)) << 3)) = (unsigned short)((i_ & 1) ? (wd_ >> 16) : (wd_ & 0xffffu)); } } while (0)
    __syncthreads();
    const int lo = min(max(r0 - 4, 0), 56);
    for (int row = lo; row < NA_HI(0); ++row) { const u32x4 v = *(const u32x4*)(vU + (size_t)(row * 64 * 3072 + vl)); NA_PUT(row, v); }
    u32x4 pre[2] = {{0u, 0u, 0u, 0u}, {0u, 0u, 0u, 0u}};
    { const int h0 = NA_HI(0), h1 = NA_HI(1);
#pragma unroll
      for (int n = 0; n < 2; ++n) if (h0 + n < h1) pre[n] = *(const u32x4*)(vU + (size_t)((h0 + n) * 64 * 3072 + vl)); }
#pragma unroll 1
    for (int it = 0; it < 16; ++it) {
        __syncthreads();
        const int h0 = NA_HI(it), h1 = NA_HI(it + 1), h2 = NA_HI(it + 2);
#pragma unroll
        for (int n = 0; n < 2; ++n) if (h0 + n < h1) NA_PUT(h0 + n, pre[n]);
#pragma unroll
        for (int n = 0; n < 2; ++n) if (h1 + n < h2) pre[n] = *(const u32x4*)(vU + (size_t)((h1 + n) * 64 * 3072 + vl));
        na_item(p, b, hd, r0 + 2 * it + (wave >> 2), wave & 3, lane, rpl, Vl);
    }
#undef NA_HI
#undef NA_PUT
}

__device__ __forceinline__ void phase_mlnorm(const Params& p) {
    const int tid = threadIdx.x, lane = tid & 63, wave = tid >> 6;
    unsigned char* ws = p.ws;
    const bf16_t* H0 = (const bf16_t*)(ws + WS_HOUT); const bf16_t* H1 = H0 + (size_t)T * 1024; const unsigned char* mlo = (const unsigned char*)(ws + WS_MLO);
    bf16_t* yml = (bf16_t*)(ws + WS_YML); const float* nw = p.in[7];
    const int NW = gridDim.x * NWAVES;
    for (int w0 = blockIdx.x * NWAVES + wave; w0 < T * 4; w0 += 4 * NW) {
        u32x2 a[4], b[4]; unsigned o[4];
#pragma unroll
        for (int u = 0; u < 4; ++u) { const int wi = min(w0 + u * NW, T * 4 - 1); const size_t off = (size_t)wi * 256 + lane * 4;
            a[u] = __builtin_nontemporal_load((const u32x2*)(H0 + off)); b[u] = __builtin_nontemporal_load((const u32x2*)(H1 + off)); o[u] = __builtin_nontemporal_load((const unsigned*)(mlo + off)); }
#pragma unroll
        for (int u = 0; u < 4; ++u) { const int wi = w0 + u * NW; if (wi >= T * 4) continue; const size_t off = (size_t)wi * 256 + lane * 4;
            float v[4] = {bflo(a[u].x) + bflo(b[u].x), bfhi(a[u].x) + bfhi(b[u].x), bflo(a[u].y) + bflo(b[u].y), bfhi(a[u].y) + bfhi(b[u].y)};
            const float mu = wave_sum((v[0] + v[1]) + (v[2] + v[3])) * (1.0f / 256.0f);
            float q = 0.f;
#pragma unroll
            for (int i = 0; i < 4; ++i) { v[i] -= mu; q += v[i] * v[i]; }
            const float rstd = 1.0f / sqrtf(wave_sum(q) * (1.0f / 256.0f) + LN_EPS);
            const f32x4 nwv = *(const f32x4*)(nw + (wi & 3) * 256 + lane * 4);
            const float og[4] = {(float)(o[u] & 0xffu) * (1.0f / 255.0f), (float)((o[u] >> 8) & 0xffu) * (1.0f / 255.0f), (float)((o[u] >> 16) & 0xffu) * (1.0f / 255.0f), (float)(o[u] >> 24) * (1.0f / 255.0f)};
            u32x2 wv; wv.x = pk2(v[0] * rstd * nwv[0] * og[0], v[1] * rstd * nwv[1] * og[1]); wv.y = pk2(v[2] * rstd * nwv[2] * og[2], v[3] * rstd * nwv[3] * og[3]);
            *(u32x2*)(yml + off) = wv; }
    }
}

__device__ __forceinline__ void phase_ln(const float* res, const bf16_t* br, float* out, const float* gam, const float* bet, bf16_t* xb) {
    const int tid = threadIdx.x, lane = tid & 63, wave = tid >> 6;
    for (int row = blockIdx.x * NWAVES + wave; row < T; row += gridDim.x * NWAVES) {
        const f32x4* xr = (const f32x4*)(res + (size_t)row * DM) + lane; const u32x2* brr = (const u32x2*)(br + (size_t)row * DM) + lane;
        f32x4 v[8]; float s = 0.f;
#pragma unroll
        for (int j = 0; j < 8; ++j) { const f32x4 xv = __builtin_nontemporal_load(xr + 64 * j); const u32x2 bw = __builtin_nontemporal_load(brr + 64 * j);
            v[j] = xv * ALPHA + (f32x4){bflo(bw.x), bfhi(bw.x), bflo(bw.y), bfhi(bw.y)}; s += (v[j][0] + v[j][1]) + (v[j][2] + v[j][3]); }
        const float mu = wave_sum(s) * (1.0f / DM); float q = 0.f;
#pragma unroll
        for (int j = 0; j < 8; ++j) { v[j] = v[j] - mu; q += (v[j][0] * v[j][0] + v[j][1] * v[j][1]) + (v[j][2] * v[j][2] + v[j][3] * v[j][3]); }
        const float rstd = 1.0f / sqrtf(wave_sum(q) * (1.0f / DM) + LN_EPS);
        f32x4* orow = (f32x4*)(out + (size_t)row * DM) + lane;
#pragma unroll
        for (int j = 0; j < 8; ++j) { const f32x4 gv = *((const f32x4*)gam + 64 * j + lane), bv = *((const f32x4*)bet + 64 * j + lane);
            const f32x4 y = v[j] * rstd * gv + bv; orow[64 * j] = y;
            if (xb) { u32x2 wv; wv.x = pk2(y[0], y[1]); wv.y = pk2(y[2], y[3]); *((u32x2*)(xb + (size_t)row * DM) + 64 * j + lane) = wv; } }
    }
}

__device__ __forceinline__ void phase_glu_fix(const Params& p) {
    unsigned char* ws = p.ws;
    const bf16_t* E = (const bf16_t*)(ws + WS_EDGE); bf16_t* act = (bf16_t*)(ws + WS_ACT);
    const float* cw = p.in[14]; const float* cb = p.in[15];
    const int n = 513 * (DFF / 4), stride = (int)gridDim.x * NTHREADS;
    for (int i = (int)blockIdx.x * NTHREADS + (int)threadIdx.x; i < n; i += stride) {
        const int k = i / (DFF / 4), j0 = (i - k * (DFF / 4)) * 4;
        const f32x4 w0 = *(const f32x4*)(cw + j0), w1 = *(const f32x4*)(cw + DFF + j0), w2 = *(const f32x4*)(cw + 2 * DFF + j0), bs = *(const f32x4*)(cb + j0);
        const bool seq_edge = ((64 * k) & 4095) == 0;
        const f32x4 z = (f32x4){0.f, 0.f, 0.f, 0.f};
        const bf16_t* Ea = E + (size_t)(k > 0 ? k - 1 : 0) * 6 * DFF + j0; const bf16_t* Eb = E + (size_t)(k < 512 ? k : 511) * 6 * DFF + j0;
#define EDG4(ptr) ({ const u32x2 w_ = *(const u32x2*)(ptr); (f32x4){bflo(w_.x), bfhi(w_.x), bflo(w_.y), bfhi(w_.y)}; })
        if (k >= 1) {
            const f32x4 gm2 = EDG4(Ea + 2 * DFF), gm1 = EDG4(Ea + 3 * DFF), v = EDG4(Ea + 5 * DFF);
            const f32x4 g0 = (k <= 511 && !seq_edge) ? EDG4(Eb + 0 * DFF) : z;
            const f32x4 y = w0 * gm2 + w1 * gm1 + w2 * g0 + bs;
            u32x2 wv; wv.x = pk2(gelu_f(y[0]) * v[0], gelu_f(y[1]) * v[1]); wv.y = pk2(gelu_f(y[2]) * v[2], gelu_f(y[3]) * v[3]);
            *(u32x2*)(act + (size_t)(64 * k - 1) * DFF + j0) = wv;
        }
        if (k <= 511) {
            const f32x4 gm1 = (k >= 1 && !seq_edge) ? EDG4(Ea + 3 * DFF) : z;
            const f32x4 g0 = EDG4(Eb + 0 * DFF), g1 = EDG4(Eb + 1 * DFF), v = EDG4(Eb + 4 * DFF);
            const f32x4 y = w0 * gm1 + w1 * g0 + w2 * g1 + bs;
            u32x2 wv; wv.x = pk2(gelu_f(y[0]) * v[0], gelu_f(y[1]) * v[1]); wv.y = pk2(gelu_f(y[2]) * v[2], gelu_f(y[3]) * v[3]);
            *(u32x2*)(act + (size_t)(64 * k) * DFF + j0) = wv;
        }
    }
}

#define XB_TMO      128
#define XB_XCNT(j)  (256  + 64 * (j))
#define XB_XSUB(j)  (1280 + 64 * (j))
#define XB_XGEN(j)  (2304 + 64 * (j))
#define XB_TOP      3328
#define XB_TOPGEN   3392
#define XCD_BAR_WORDS 3456
#define XB_SPIN_CAP (1u << 18)

__device__ __forceinline__ unsigned xb_ld(unsigned* p)              { return __hip_atomic_load(p, __ATOMIC_RELAXED, __HIP_MEMORY_SCOPE_AGENT); }
__device__ __forceinline__ unsigned xb_add(unsigned* p, unsigned v) { return __hip_atomic_fetch_add(p, v, __ATOMIC_RELAXED, __HIP_MEMORY_SCOPE_AGENT); }
__device__ __forceinline__ unsigned xb_xcc_id() { return (unsigned)__builtin_amdgcn_s_getreg((3 << 11) | 20) & 0xFu; }
#define XB_SPIN(cond, bar) do { unsigned _sp = 0; while (cond) { __builtin_amdgcn_s_sleep(1); \
    if ((++_sp & 255u) == 0u) { if (xb_ld(&(bar)[XB_TMO])) break; if (_sp > XB_SPIN_CAP) { atomicAdd(&(bar)[XB_TMO], 1u); break; } } } } while (0)

struct XcdBarrier {
    unsigned* bar; unsigned x;
    volatile LAS unsigned* st;
};

__device__ __forceinline__ XcdBarrier xcd_barrier_post(unsigned* bar, volatile LAS unsigned* st) {
    XcdBarrier b; b.bar = bar; b.x = xb_xcc_id(); b.st = st;
    if (threadIdx.x == 0) (void)xb_add(&bar[XB_XCNT(b.x)], 1u);
    return b;
}
__device__ __forceinline__ void xcd_barrier_complete(unsigned* bar, unsigned x, unsigned& nloc, unsigned& nx) {
    const unsigned G = gridDim.x * gridDim.y * gridDim.z;
    unsigned sum, cnt, mine, sp = 0u;
    for (;;) {
        sum = 0u; cnt = 0u; mine = 0u;
#pragma unroll
        for (unsigned j = 0; j < 16; ++j) { const unsigned c = xb_ld(&bar[XB_XCNT(j)]); sum += c; cnt += (c > 0u) ? 1u : 0u; mine = (j == x) ? c : mine; }
        if (sum == G) break;
        __builtin_amdgcn_s_sleep(1);
        if ((++sp & 255u) == 0u) { if (xb_ld(&bar[XB_TMO])) break; if (sp > XB_SPIN_CAP) { atomicAdd(&bar[XB_TMO], 1u); break; } }
    }
    nloc = mine > 0u ? mine : 1u; nx = cnt > 0u ? cnt : 1u;
}

__device__ __forceinline__ void xcd_barrier(const XcdBarrier& b) {
    asm volatile("s_waitcnt vmcnt(0)" ::: "memory");
    __syncthreads();
    if (threadIdx.x == 0) {
        unsigned* bar = b.bar;
        __builtin_amdgcn_s_waitcnt(0);
        unsigned nloc = b.st[0], nx = b.st[1];
        if (nloc == 0u) { xcd_barrier_complete(bar, b.x, nloc, nx); b.st[0] = nloc; b.st[1] = nx; }
        const unsigned old = xb_add(&bar[XB_XSUB(b.x)], 1u);
        const unsigned gen = old / nloc;
        if (old + 1u == (gen + 1u) * nloc) {
            __builtin_amdgcn_fence(__ATOMIC_RELEASE, "agent");
            asm volatile("s_waitcnt vmcnt(0)" ::: "memory");
            const unsigned og = xb_add(&bar[XB_TOP], 1u);
            const unsigned tg = og / nx;
            if (og + 1u == (tg + 1u) * nx) xb_add(&bar[XB_TOPGEN], 1u);
            else XB_SPIN(xb_ld(&bar[XB_TOPGEN]) == tg, bar);
            __builtin_amdgcn_fence(__ATOMIC_ACQUIRE, "agent");
            xb_add(&bar[XB_XGEN(b.x)], 1u);
            asm volatile("s_waitcnt vmcnt(0)" ::: "memory");
        } else {
            XB_SPIN(xb_ld(&bar[XB_XGEN(b.x)]) == gen, bar);
            __builtin_amdgcn_fence(__ATOMIC_ACQUIRE, "agent");
            asm volatile("s_waitcnt vmcnt(0)" ::: "memory");
        }
    }
    __syncthreads();
}


__global__ void __launch_bounds__(NTHREADS, 2) fwd_kernel(Params p) {
    extern __shared__ __attribute__((aligned(16))) unsigned char lds[];
    unsigned char* ws = p.ws; unsigned char* dout = (unsigned char*)p.out;
    const int G = gridDim.x, cid = blockIdx.x;
    PG8_LAS unsigned char* ring = (PG8_LAS unsigned char*)lds;
#define RUN(k) (p.ph_lo <= (k) && (k) < p.ph_hi)
    {   volatile LAS unsigned* misc = (volatile LAS unsigned*)((LAS unsigned char*)lds + 147392);
        if (threadIdx.x < 16) misc[threadIdx.x] = 0u;
        __syncthreads(); }
    const XcdBarrier xbar = xcd_barrier_post((unsigned*)ws + p.li * XCD_BAR_WORDS, (volatile LAS unsigned*)((LAS unsigned char*)lds + 147392 + 32));
#define SEAM(k) do { if (RUN(k) && RUN((k) + 1)) { if ((k) == 0) cg::this_grid().sync(); else xcd_barrier(xbar); } } while (0)
    if (RUN(0)) phase_prologue(p, lds);
    SEAM(0);
    if (RUN(1)) {
        pg8::Gemm g{(const bf16_t*)(ws + WS_XB), (const bf16_t*)(ws + WS_WIN), T, N1, DM}; pg8::StaticOrder S; S.init(T, N1, G, cid);
        EpiProj E{(bf16_t*)(ws + WS_NAQKV), (bf16_t*)(ws + WS_MLQK), (bf16_t*)(ws + WS_MLV), (bf16_t*)(ws + WS_MLO), (bf16_t*)(ws + WS_MG), (float*)(ws + WS_GATES)};
        pg8::gemm_phase<EpiProj, pg8::StaticOrder, true, true>(ring, g, S, E);
    }
    SEAM(1);
    if (RUN(2)) phase_prep(p, lds);
    SEAM(2);
    if (RUN(3)) {
        const int vcu = (G % 8 == 0) ? (cid & 7) * (G >> 3) + (cid >> 3) : cid;
        if (p.flags & 1) for (int v = vcu; v < 256; v += G) { const int bh = v >> 3, g_ = (v >> 2) & 1, es_ = v & 3; scan_item(p, (g_ * 32 + bh) * 4 + es_, lds); }
        const int lane = threadIdx.x & 63, wave = threadIdx.x >> 6;
        if (p.flags & 2) {
            float* rpl = (float*)lds;
            for (int i = threadIdx.x; i < 16 * 15 * 31; i += NTHREADS) rpl[i] = p.in[2][i];
            __syncthreads();
            for (int wgi = vcu; wgi < 256; wgi += G) na_wg_item(p, wgi, lds, rpl);
        }
    }
    SEAM(3);
    if (RUN(4)) phase_mlnorm(p);
    SEAM(4);
    if (RUN(5)) {
        pg8::Gemm g{(const bf16_t*)(dout + DO_YNA), (const bf16_t*)(ws + WS_WBNA), T, DM, 1024, (const bf16_t*)(ws + WS_YML), (const bf16_t*)(ws + WS_WBML)};
        MergeOrder S; S.base.init(T, DM, G, cid);
        EpiMerge E{(const bf16_t*)(ws + WS_MG), (bf16_t*)(ws + WS_MIXED)};
        pg8::gemm_phase<EpiMerge, MergeOrder, true, true>(ring, g, S, E);
    }
    SEAM(6);
    if (RUN(7)) {
        pg8::Gemm g{(const bf16_t*)(ws + WS_MIXED), (const bf16_t*)(ws + WS_WOUT), T, DM, DM}; pg8::StaticOrder S; S.init(T, DM, G, cid);
        EpiPlainBf16 E{(bf16_t*)(ws + WS_BR1), DM};
        pg8::gemm_phase<EpiPlainBf16, pg8::StaticOrder, true, true>(ring, g, S, E);
    }
    SEAM(7);
    if (RUN(8)) phase_ln(p.in[0], (const bf16_t*)(ws + WS_BR1), p.out, p.in[11], p.in[12], (bf16_t*)(ws + WS_X1B));
    SEAM(8);
    if (RUN(9)) {
        pg8::Gemm g{(const bf16_t*)(ws + WS_X1B), (const bf16_t*)(ws + WS_WUP), T, NUP, DM}; pg8::StaticOrder S; S.init(T, NUP, G, cid);
        EpiGlu E{(bf16_t*)(ws + WS_ACT), (bf16_t*)(ws + WS_EDGE), p.in[14], p.in[15]};
        pg8::gemm_phase<EpiGlu, pg8::StaticOrder, true, true>(ring, g, S, E);
    }
    SEAM(9);
    if (RUN(10)) phase_glu_fix(p);
    SEAM(10);
    if (RUN(11)) {
        pg8::Gemm g{(const bf16_t*)(ws + WS_ACT), (const bf16_t*)(ws + WS_WDN), T, DM, DFF}; pg8::StaticOrder S; S.init(T, DM, G, cid);
        EpiPlainBf16 E{(bf16_t*)(ws + WS_BR2), DM};
        pg8::gemm_phase<EpiPlainBf16, pg8::StaticOrder, true, true>(ring, g, S, E);
    }
    SEAM(11);
    if (RUN(12)) phase_ln(p.out, (const bf16_t*)(ws + WS_BR2), p.out, p.in[17], p.in[18], nullptr);
#undef RUN
#undef SEAM
}

extern "C" void kernel_launch(void* const* d_in, const int* in_sizes, int n_in, void* d_out, int out_size, void* d_ws, size_t ws_size, hipStream_t stream) {
    static int grid = 0;
    if (grid == 0) {
        if (n_in != 19 || out_size != T * DM || ws_size < WS_END) { fprintf(stderr, "kernel_launch: unexpected shapes (n_in %d out %d ws %zu)\n", n_in, out_size, ws_size); grid = -1; return; }
        int dev = 0, cus = 0, per_cu = 0;
        hipGetDevice(&dev); hipDeviceGetAttribute(&cus, hipDeviceAttributeMultiprocessorCount, dev);
        hipFuncSetAttribute((const void*)fwd_kernel, hipFuncAttributeMaxDynamicSharedMemorySize, LDS_BYTES);
        hipOccupancyMaxActiveBlocksPerMultiprocessor(&per_cu, (const void*)fwd_kernel, NTHREADS, LDS_BYTES);
        if (per_cu < 1) { fprintf(stderr, "kernel_launch: occupancy query says %d blocks per CU\n", per_cu); per_cu = 1; }
        (void)hipGetLastError();
        grid = cus;
    }
    if (grid < 0) return;
    Params p{};
    for (int i = 0; i < 19; ++i) p.in[i] = (const float*)d_in[i];
    p.out = (float*)d_out; p.ws = (unsigned char*)d_ws;
    p.flags = 3; p.li = 0;
    (void)hipMemsetAsync(d_ws, 0, 65536, stream);
#if defined(PROBE_PHASE)
    const int cuts[4] = {0, PROBE_PHASE + 1, PROBE_PHASE + 1, NPHASE}; const int los[3] = {0, PROBE_PHASE, PROBE_PHASE + 1};
    for (int k = 0; k < 3; ++k) { p.ph_lo = los[k]; p.ph_hi = (k == 0) ? cuts[1] : (k == 1 ? PROBE_PHASE + 1 : NPHASE); p.flags = (k == 1) ? PROBE_FLAGS : 3; p.li = k; if (p.ph_lo >= p.ph_hi) continue; void* args[] = {&p};
        hipError_t e = hipLaunchCooperativeKernel((const void*)fwd_kernel, dim3(grid), dim3(NTHREADS), args, LDS_BYTES, stream);
        if (e != hipSuccess) fprintf(stderr, "launch %d failed: %s\n", k, hipGetErrorString(e)); }
#elif MK_N_LAUNCHES == 1
    p.ph_lo = 0; p.ph_hi = NPHASE;
    void* args[] = {&p};
    hipError_t e = hipLaunchCooperativeKernel((const void*)fwd_kernel, dim3(grid), dim3(NTHREADS), args, LDS_BYTES, stream);
    if (e != hipSuccess) fprintf(stderr, "cooperative launch failed: %s (grid %d)\n", hipGetErrorString(e), grid);
#else
    for (int k = 0; k < NPHASE; ++k) { p.ph_lo = k; p.ph_hi = k + 1; void* args[] = {&p};
        hipError_t e = hipLaunchCooperativeKernel((const void*)fwd_kernel, dim3(grid), dim3(NTHREADS), args, LDS_BYTES, stream);
        if (e != hipSuccess) fprintf(stderr, "launch %d failed: %s\n", k, hipGetErrorString(e)); }
#endif
}
```

```cpp
#include <hip/hip_runtime.h>
#include <hip/hip_cooperative_groups.h>
#include <cstdio>
#include <cstdint>
namespace cg = cooperative_groups;
#ifndef MK_N_LAUNCHES
#define MK_N_LAUNCHES 1
#endif
namespace pg8 {
#define PG8_LAS __attribute__((address_space(3)))
typedef unsigned short bf16_t;
typedef short bf16x8 __attribute__((ext_vector_type(8)));
typedef float f32x4 __attribute__((ext_vector_type(4)));
typedef unsigned u32x4 __attribute__((ext_vector_type(4)));
constexpr int BM = 256, BK = 64, HALF = 128, HTB = HALF * BK * 2  , STAGE_BYTES = 8 * HTB, NXCD = 8, WGM = 8;

__host__ __device__ __forceinline__ int lds_byte(int r, int c) { const int st = (r >> 4) * 2 + (c >> 5), rr = r & 15, cc = c & 31, ob = rr * 64 + cc * 2; return st * 1024 + (ob ^ (((ob >> 9) & 1) << 5)); }
__host__ __device__ __forceinline__ void stage_rc(int b, int& R, int& C) { const int st = b / 1024, sb = b % 1024, swz = sb ^ (((sb >> 9) & 1) << 5); R = (st >> 1) * 16 + swz / 64; C = (st & 1) * 32 + (swz % 64) / 2; }
__host__ __device__ __forceinline__ int perm32(int rho) { const int n = rho >> 4, i = rho & 15; return 8 * (i >> 2) + 4 * n + (i & 3); }

struct Unit { int pm, pn, seg; };
struct Gemm { const bf16_t* A; const bf16_t* Bt; int M, N, K; const bf16_t* A2; const bf16_t* Bt2; };

struct StaticOrder {
    int nM, nN, nwg, G, c;
    __host__ __device__ void init(int M, int N, int G_, int c_) { nM = M / BM; nN = N / BM; nwg = nM * nN; G = G_; c = c_; }
    __host__ __device__ bool next(int i, Unit& u) const {
        const long L = (long)i * G + c; if (L >= nwg) return false;
        int wgid = (int)L; { const int q = nwg / NXCD, r = nwg % NXCD, xcd = wgid % NXCD, off = wgid / NXCD; wgid = (xcd < r ? xcd * (q + 1) : r * (q + 1) + (xcd - r) * q) + off; }
        const int nig = WGM * nN, gid = wgid / nig, fm = gid * WGM, gsz = (nM - fm) < WGM ? (nM - fm) : WGM;
        u.pm = fm + ((wgid % nig) % gsz); u.pn = (wgid % nig) / gsz; u.seg = 0; return true;
    }
    __device__ __forceinline__ void a_ready(const Unit&) const {}
    __device__ __forceinline__ void done(const Unit&) const {}
};

__device__ __forceinline__ unsigned cvt_pk_bf16(float lo, float hi) { unsigned r; asm volatile("v_cvt_pk_bf16_f32 %0, %1, %2" : "=v"(r) : "v"(lo), "v"(hi)); return r; }
typedef float f32x2 __attribute__((ext_vector_type(2)));
template <class Epi, class Sched, bool ALIGN_EPI = false, bool SP2 = false>
__device__ __forceinline__ void gemm_phase(PG8_LAS unsigned char* lds, const Gemm g, const Sched& S, const Epi& E) {
    const int tid = threadIdx.x, wid = __builtin_amdgcn_readfirstlane(tid >> 6), lane = tid & 63, wr = wid >> 2, wc = wid & 3, fr = lane & 15, fq = lane >> 4;
    const int K = g.K, nt = K / BK;
    unsigned voffA[2], voffB[2];
#pragma unroll
    for (int i = 0; i < 2; ++i) { int R, C; stage_rc(tid * 16 + i * 8192, R, C); const int Rb = Epi::PERM ? ((R & ~31) + perm32(R & 31)) : R;
        voffA[i] = (unsigned)(R * K + C) * 2u; voffB[i] = (unsigned)(Rb * K + C) * 2u; }
    const size_t kstep = (size_t)(BK * 2);
    const size_t hstep = (size_t)HALF * K * 2;
    const size_t tstep = 2 * hstep;
    const unsigned ldsw = (unsigned)wid * 1024u;
    const int aoff = lds_byte(wr * 64 + fr, fq * 8), boff = lds_byte(wc * 32 + fr, fq * 8);
#define PG8_SA(b, h) (((b) * 2 + (h)) * HTB)
#define PG8_SB(b, h) ((4 + (b) * 2 + (h)) * HTB)
#define PG8_STAGE(bufoff, gbase, voff) do { _Pragma("unroll") for (int _i = 0; _i < 2; ++_i) \
        __builtin_amdgcn_global_load_lds((const unsigned*)((const char*)(gbase) + (voff)[_i]), (PG8_LAS unsigned*)(lds + (bufoff) + ldsw + _i * 8192), 16, 0, 0); } while (0)
#define PG8_LDA(dst, b, h) do { _Pragma("unroll") for (int m = 0; m < 4; ++m) _Pragma("unroll") for (int k = 0; k < 2; ++k) dst[m][k] = *(const PG8_LAS bf16x8*)(lds + PG8_SA(b, h) + aoff + m * 2048 + k * 1024); } while (0)
#define PG8_LDB(dst, b, h) do { _Pragma("unroll") for (int n = 0; n < 2; ++n) _Pragma("unroll") for (int k = 0; k < 2; ++k) dst[n][k] = *(const PG8_LAS bf16x8*)(lds + PG8_SB(b, h) + boff + n * 2048 + k * 1024); } while (0)
#define PG8_MMA(ai, bj, At, Bt) do { __builtin_amdgcn_s_setprio(1); _Pragma("unroll") for (int m = 0; m < 4; ++m) _Pragma("unroll") for (int n = 0; n < 2; ++n) _Pragma("unroll") for (int k = 0; k < 2; ++k) \
        acc[ai][bj][m][n] = __builtin_amdgcn_mfma_f32_16x16x32_bf16(Bt[n][k], At[m][k], acc[ai][bj][m][n], 0, 0, 0); __builtin_amdgcn_s_setprio(0); } while (0)
#define PG8_WAIT_V(n) asm volatile("s_waitcnt vmcnt(" #n ")" ::: "memory")
#define PG8_WAIT_L(n) asm volatile("s_waitcnt lgkmcnt(" #n ")" ::: "memory")
#define PG8_BAR __builtin_amdgcn_s_barrier()
#define PG8_SCHED __builtin_amdgcn_sched_barrier(0)
    Unit cur, nxt; int ui = 0;
    if (!S.next(0, cur)) return;
    f32x4 acc[2][2][4][2];
#pragma unroll
    for (int a = 0; a < 2; ++a)
#pragma unroll
        for (int b = 0; b < 2; ++b)
#pragma unroll
            for (int m = 0; m < 4; ++m)
#pragma unroll
                for (int n = 0; n < 2; ++n) acc[a][b][m][n] = (f32x4){0.f, 0.f, 0.f, 0.f};
    bf16x8 At[4][2], B0[2][2], B1[2][2];
    const char* cA = (const char*)(cur.seg ? g.A2 : g.A) + (size_t)cur.pm * tstep; const char* cB = (const char*)(cur.seg ? g.Bt2 : g.Bt) + (size_t)cur.pn * tstep;
    S.a_ready(cur);
    if constexpr (SP2) {
        PG8_STAGE(PG8_SB(0, 0), cB, voffB); PG8_STAGE(PG8_SB(0, 1), cB + hstep, voffB); PG8_STAGE(PG8_SA(0, 0), cA, voffA); PG8_STAGE(PG8_SA(0, 1), cA + hstep, voffA);
        if (wr == 1) PG8_BAR;
        PG8_WAIT_V(2); PG8_BAR;
        PG8_STAGE(PG8_SB(1, 0), cB + kstep, voffB); PG8_STAGE(PG8_SA(1, 0), cA + kstep, voffA); PG8_STAGE(PG8_SB(1, 1), cB + hstep + kstep, voffB);
        PG8_WAIT_V(6); PG8_BAR;
    } else {
        PG8_STAGE(PG8_SB(0, 0), cB, voffB); PG8_STAGE(PG8_SA(0, 0), cA, voffA); PG8_STAGE(PG8_SB(0, 1), cB + hstep, voffB); PG8_STAGE(PG8_SA(0, 1), cA + hstep, voffA);
        if (wr == 1) PG8_BAR;
        PG8_WAIT_V(4); PG8_BAR;
        PG8_STAGE(PG8_SB(1, 0), cB + kstep, voffB); PG8_STAGE(PG8_SA(1, 0), cA + kstep, voffA); PG8_STAGE(PG8_SB(1, 1), cB + hstep + kstep, voffB);
        PG8_WAIT_V(6); PG8_BAR;
    }
    for (;;) {
        const bool has_next = S.next(ui + 1, nxt);
        const char* nA = has_next ? (const char*)(nxt.seg ? g.A2 : g.A) + (size_t)nxt.pm * tstep : cA; const char* nB = has_next ? (const char*)(nxt.seg ? g.Bt2 : g.Bt) + (size_t)nxt.pn * tstep : cB;
        for (int t = 0; t < nt; t += 2) {
            const bool last = (t == nt - 2);
            const char* a1 = cA + (size_t)(t + 1) * kstep;
            const char* a2 = last ? nA : cA + (size_t)(t + 2) * kstep; const char* b2 = last ? nB : cB + (size_t)(t + 2) * kstep;
            const char* a3 = a2 + kstep; const char* b3 = b2 + kstep;
            if (last && has_next) S.a_ready(nxt);
            if constexpr (SP2) {
            PG8_LDB(B0, 0, 0); PG8_LDB(B1, 0, 1); PG8_SCHED; PG8_LDA(At, 0, 0); PG8_STAGE(PG8_SA(1, 1), a1 + hstep, voffA);
            PG8_WAIT_V(8); PG8_WAIT_L(0); PG8_BAR; PG8_MMA(0, 0, At, B0); PG8_MMA(0, 1, At, B1); PG8_BAR; PG8_SCHED;
            PG8_LDA(At, 0, 1); PG8_STAGE(PG8_SB(0, 0), b2, voffB); PG8_STAGE(PG8_SB(0, 1), b2 + hstep, voffB); PG8_STAGE(PG8_SA(0, 0), a2, voffA);
            PG8_WAIT_V(8); PG8_WAIT_L(0); PG8_BAR; PG8_MMA(1, 0, At, B0); PG8_MMA(1, 1, At, B1); PG8_BAR; PG8_SCHED;
            PG8_LDB(B0, 1, 0); PG8_LDB(B1, 1, 1); PG8_SCHED; PG8_LDA(At, 1, 0); PG8_STAGE(PG8_SA(0, 1), a2 + hstep, voffA);
            PG8_WAIT_V(8); PG8_WAIT_L(0); PG8_BAR; PG8_MMA(0, 0, At, B0); PG8_MMA(0, 1, At, B1); PG8_BAR; PG8_SCHED;
            PG8_LDA(At, 1, 1); PG8_STAGE(PG8_SB(1, 0), b3, voffB); PG8_STAGE(PG8_SB(1, 1), b3 + hstep, voffB); PG8_STAGE(PG8_SA(1, 0), a3, voffA);
            PG8_WAIT_V(8); PG8_WAIT_L(0); PG8_BAR; PG8_MMA(1, 0, At, B0); PG8_MMA(1, 1, At, B1); PG8_BAR; PG8_SCHED;
            } else {
            PG8_LDB(B0, 0, 0); PG8_SCHED; PG8_LDA(At, 0, 0); PG8_STAGE(PG8_SA(1, 1), a1 + hstep, voffA);
            PG8_WAIT_L(8); PG8_BAR; PG8_WAIT_L(0); PG8_MMA(0, 0, At, B0); PG8_BAR; PG8_SCHED;
            PG8_LDB(B1, 0, 1); PG8_STAGE(PG8_SB(0, 0), b2, voffB);
            PG8_BAR; PG8_WAIT_L(0); PG8_MMA(0, 1, At, B1); PG8_BAR;
            PG8_LDA(At, 0, 1); PG8_STAGE(PG8_SA(0, 0), a2, voffA);
            PG8_BAR; PG8_WAIT_L(0); PG8_MMA(1, 0, At, B0); PG8_BAR; PG8_SCHED;
            PG8_STAGE(PG8_SB(0, 1), b2 + hstep, voffB);
            PG8_WAIT_V(6); PG8_BAR; PG8_MMA(1, 1, At, B1); PG8_BAR;
            PG8_LDB(B0, 1, 0); PG8_SCHED; PG8_LDA(At, 1, 0); PG8_STAGE(PG8_SA(0, 1), a2 + hstep, voffA);
            PG8_WAIT_L(8); PG8_BAR; PG8_WAIT_L(0); PG8_MMA(0, 0, At, B0); PG8_BAR; PG8_SCHED;
            PG8_LDB(B1, 1, 1); PG8_STAGE(PG8_SB(1, 0), b3, voffB);
            PG8_BAR; PG8_WAIT_L(0); PG8_MMA(0, 1, At, B1); PG8_BAR;
            PG8_LDA(At, 1, 1); PG8_STAGE(PG8_SA(1, 0), a3, voffA);
            PG8_BAR; PG8_WAIT_L(0); PG8_MMA(1, 0, At, B0); PG8_BAR; PG8_SCHED;
            PG8_STAGE(PG8_SB(1, 1), b3 + hstep, voffB);
            PG8_WAIT_V(6); PG8_BAR; PG8_MMA(1, 1, At, B1); PG8_BAR;
            }
        }
        if constexpr (ALIGN_EPI) { if (wr == 0) PG8_BAR; }
        if constexpr (!Epi::AFTER_DRAIN) { E(acc, cur, wr, wc, fr, fq); S.done(cur); }
        if (!has_next) break;
        if (!(Epi::CHAIN && cur.seg == 0)) {
#pragma unroll
        for (int a = 0; a < 2; ++a)
#pragma unroll
            for (int b = 0; b < 2; ++b)
#pragma unroll
                for (int m = 0; m < 4; ++m)
#pragma unroll
                    for (int n = 0; n < 2; ++n) acc[a][b][m][n] = (f32x4){0.f, 0.f, 0.f, 0.f};
        }
        cur = nxt; cA = nA; cB = nB; ++ui;
        if constexpr (ALIGN_EPI) { if (wr == 1) PG8_BAR; }
    }
    PG8_WAIT_V(0);
    if constexpr (!ALIGN_EPI) { if (wr == 0) PG8_BAR; }
    PG8_BAR;
    if constexpr (Epi::AFTER_DRAIN) { E.fused(acc, cur, wr, wc, fr, fq, lds, wid, lane); S.done(cur); }
#undef PG8_SA
#undef PG8_SB
#undef PG8_STAGE
#undef PG8_LDA
#undef PG8_LDB
#undef PG8_MMA
#undef PG8_WAIT_V
#undef PG8_WAIT_L
#undef PG8_BAR
#undef PG8_SCHED
}
}

#define LAS __attribute__((address_space(3)))
typedef unsigned short bf16_t;
typedef float f32x4 __attribute__((ext_vector_type(4)));
typedef short bf16x8 __attribute__((ext_vector_type(8)));
typedef unsigned u32x4 __attribute__((ext_vector_type(4)));
typedef unsigned u32x2 __attribute__((ext_vector_type(2)));

constexpr int T = 32768, DM = 2048, SEQ = 4096, NBATCH = 8;
constexpr int N1 = 11520;
constexpr int DFF = 5504, NUP = 11008;
constexpr int NWAVES = 8, NTHREADS = 512;
constexpr int LDS_BYTES = 147456;
constexpr float LN_EPS = 1e-5f;
constexpr float ALPHA = 1.189207115002721f;
constexpr int NPHASE = 13;

constexpr size_t MiB = 1u << 20;
constexpr size_t WS_WIN = 1 * MiB, WS_WBNA = 46 * MiB, WS_WBML = 50 * MiB, WS_WOUT = 54 * MiB, WS_WUP = 62 * MiB, WS_WDN = 105 * MiB;
constexpr size_t WS_GATES = 127 * MiB, WS_BV = 129 * MiB, WS_AV = 130 * MiB, WS_PMV = 131 * MiB, WS_BL = 132 * MiB, WS_AM = 132 * MiB + 65536;
constexpr size_t WS_XB = 136 * MiB, WS_NAQKV = 264 * MiB, WS_MLQK = 456 * MiB, WS_MLV = 584 * MiB, WS_MLO = 648 * MiB, WS_MG = 712 * MiB;
constexpr size_t WS_QC = 136 * MiB, WS_KC = 200 * MiB;
constexpr size_t WS_HOUT = 456 * MiB, WS_YML = 584 * MiB, WS_TMP = 136 * MiB, WS_MIXED = 456 * MiB, WS_X1B = 136 * MiB;
constexpr size_t WS_BR1 = 264 * MiB, WS_BR2 = 136 * MiB;
constexpr size_t WS_EDGE = 264 * MiB, WS_ACT = 608 * MiB, WS_END = 968 * MiB;
constexpr size_t DO_SPRE = 0;
constexpr size_t DO_KCT = 0, DO_VTML = 64 * MiB, DO_VTNA = 128 * MiB, DO_YNA = 192 * MiB;

struct Params { const float* in[19]; float* out; unsigned char* ws; int ph_lo, ph_hi, flags, li; };

__device__ __forceinline__ unsigned f2bf(float f) { unsigned u = __builtin_bit_cast(unsigned, f); return (u + 0x7fffu + ((u >> 16) & 1u)) >> 16; }
__device__ __forceinline__ unsigned pk2(float lo, float hi) { unsigned r; asm("v_cvt_pk_bf16_f32 %0, %1, %2" : "=v"(r) : "v"(lo), "v"(hi)); return r; }
__device__ __forceinline__ float bflo(unsigned w) { return __builtin_bit_cast(float, w << 16); }
__device__ __forceinline__ float bfhi(unsigned w) { return __builtin_bit_cast(float, w & 0xffff0000u); }
__device__ __forceinline__ float sigmoidf_(float x) { return __builtin_amdgcn_rcpf(1.0f + __expf(-x)); }
__device__ __forceinline__ float gelu_f(float v) {
    const float av = fabsf(v), t = __builtin_amdgcn_rcpf(av * 0.2316418882f + 1.0f);
    float q = t * 0.5307027145f + (-0.7265760135f); q = q * t + 0.7107068705f; q = q * t + (-0.142248368f); q = q * t + 0.127414796f; q = q * t;
    const float e = __builtin_amdgcn_exp2f(v * v * (-0.72134752044f)), m = v * (q * e);
    return v < 0.f ? m : v - m;
}
__device__ __forceinline__ f32x4 mfma16(bf16x8 a, bf16x8 b, f32x4 c) { return __builtin_amdgcn_mfma_f32_16x16x32_bf16(a, b, c, 0, 0, 0); }
__device__ __forceinline__ bf16x8 mk8(u32x2 lo, u32x2 hi) { u32x4 w; w.x = lo.x; w.y = lo.y; w.z = hi.x; w.w = hi.y; return __builtin_bit_cast(bf16x8, w); }

__device__ __forceinline__ void store_tile_bf16(const f32x4 (&acc)[2][2][4][2], bf16_t* base, size_t ldc, int row0, int col0) {
#pragma unroll
    for (int ai = 0; ai < 2; ++ai)
#pragma unroll
        for (int m = 0; m < 4; ++m) { bf16_t* rowp = base + (size_t)(row0 + ai * 128 + m * 16) * ldc + col0;
#pragma unroll
            for (int bj = 0; bj < 2; ++bj) { const f32x4 v0 = acc[ai][bj][m][0], v1 = acc[ai][bj][m][1];
                u32x4 w; w.x = pg8::cvt_pk_bf16(v0[0], v0[1]); w.y = pg8::cvt_pk_bf16(v0[2], v0[3]); w.z = pg8::cvt_pk_bf16(v1[0], v1[1]); w.w = pg8::cvt_pk_bf16(v1[2], v1[3]);
                *(u32x4*)(rowp + bj * 128) = w; } }
}
struct EpiProj {
    static constexpr bool PERM = true, AFTER_DRAIN = false, CHAIN = false;
    bf16_t *naqkv, *mlqk, *mlv, *mlo, *mg; float* gates;
    __device__ __forceinline__ void operator()(const f32x4 (&acc)[2][2][4][2], const pg8::Unit& u, int wr, int wc, int fr, int fq) const {
        const int pn = u.pn, row0 = u.pm * 256 + wr * 64 + fr;
        if (pn == 44) {
            if (wc == 0 && fq < 2) {
#pragma unroll
                for (int ai = 0; ai < 2; ++ai)
#pragma unroll
                    for (int m = 0; m < 4; ++m) { float* gp = gates + (size_t)(row0 + ai * 128 + m * 16) * 16 + 8 * fq;
                        *(f32x4*)gp = acc[ai][0][m][0]; *(f32x4*)(gp + 4) = acc[ai][0][m][1]; }
            }
            return;
        }
        bf16_t* base; int ldc, colt;
        if (pn < 12) { base = naqkv; ldc = 3072; colt = pn * 256; }
        else if (pn < 20) { base = mlqk; ldc = 2048; colt = (pn - 12) * 256; }
        else if (pn < 24) { base = mlv; ldc = 1024; colt = (pn - 20) * 256; }
        else {
            const bool og = pn < 28; unsigned char* gq = (unsigned char*)(og ? mlo : mg); const int gld = og ? 1024 : 4096; const int col0 = (pn - (og ? 24 : 28)) * 256 + wc * 32 + 8 * fq;
#pragma unroll
            for (int ai = 0; ai < 2; ++ai)
#pragma unroll
                for (int m = 0; m < 4; ++m) { unsigned char* rowp = gq + (size_t)(row0 + ai * 128 + m * 16) * gld + col0;
#pragma unroll
                    for (int bj = 0; bj < 2; ++bj) { unsigned w2[2];
#pragma unroll
                        for (int n = 0; n < 2; ++n) { unsigned wv = 0u;
#pragma unroll
                            for (int e = 0; e < 4; ++e) { const float gsig = sigmoidf_(acc[ai][bj][m][n][e]); const float qf_ = fminf(fmaxf(__builtin_rintf(gsig * 255.0f), 1.0f), 255.0f); wv |= (unsigned)qf_ << (8 * e); }
                            w2[n] = wv; }
                        *(u32x2*)(rowp + bj * 128) = (u32x2){w2[0], w2[1]}; } }
            return;
        }
        store_tile_bf16(acc, base, (size_t)ldc, row0, colt + wc * 32 + 8 * fq);
    }
};
struct EpiPlainBf16 {
    static constexpr bool PERM = true, AFTER_DRAIN = false, CHAIN = false;
    bf16_t* O; int ldc;
    __device__ __forceinline__ void operator()(const f32x4 (&acc)[2][2][4][2], const pg8::Unit& u, int wr, int wc, int fr, int fq) const {
        store_tile_bf16(acc, O, (size_t)ldc, u.pm * 256 + wr * 64 + fr, u.pn * 256 + wc * 32 + 8 * fq);
    }
};
template <int MODE> struct EpiF32 {
    static constexpr bool PERM = true, AFTER_DRAIN = false, CHAIN = false;
    const bf16_t* mg; const float* src; float* dst; bf16_t* dstb;
    __device__ __forceinline__ void operator()(const f32x4 (&acc)[2][2][4][2], const pg8::Unit& u, int wr, int wc, int fr, int fq) const {
        const int row0 = u.pm * 256 + wr * 64 + fr, col0 = u.pn * 256 + wc * 32 + 8 * fq;
#pragma unroll
        for (int ai = 0; ai < 2; ++ai)
#pragma unroll
            for (int m = 0; m < 4; ++m) { const size_t r = (size_t)(row0 + ai * 128 + m * 16);
#pragma unroll
                for (int bj = 0; bj < 2; ++bj)
#pragma unroll
                    for (int n = 0; n < 2; ++n) { const int c = col0 + bj * 128 + n * 4; const f32x4 a = acc[ai][bj][m][n];
                        if (MODE == 0 || MODE == 1) {
                            const u32x2 gw = *(const u32x2*)(mg + r * 4096 + (MODE == 1 ? 2048 : 0) + c);
                            f32x4 gt; gt[0] = sigmoidf_(bflo(gw.x)); gt[1] = sigmoidf_(bfhi(gw.x)); gt[2] = sigmoidf_(bflo(gw.y)); gt[3] = sigmoidf_(bfhi(gw.y));
                            if (MODE == 0) { *(f32x4*)(dst + r * 2048 + c) = gt * a; }
                            else { const f32x4 t = *(const f32x4*)(src + r * 2048 + c) + gt * a; u32x2 w; w.x = pk2(t[0], t[1]); w.y = pk2(t[2], t[3]); *(u32x2*)(dstb + r * 2048 + c) = w; }
                        } else {
                            const f32x4 xv = *(const f32x4*)(src + r * 2048 + c);
                            *(f32x4*)(dst + r * 2048 + c) = xv * ALPHA + a;
                        }
                    } }
    }
};

struct EpiGlu {
    static constexpr bool PERM = true, AFTER_DRAIN = false, CHAIN = false;
    bf16_t* act; bf16_t* edge; const float* cw; const float* cb;
    __device__ __forceinline__ void operator()(const f32x4 (&acc)[2][2][4][2], const pg8::Unit& u, int wr, int wc, int fr, int fq) const {
        const int j0 = u.pn * 128 + wc * 32 + 8 * fq;
        const int lane = fq * 16 + fr, psrc = (lane & 48) | ((fr + 15) & 15), nsrc = (lane & 48) | ((fr + 1) & 15);
#pragma unroll
        for (int ai = 0; ai < 2; ++ai) {
            const int kb = u.pm * 4 + ai * 2 + wr;
            bf16_t* eb = edge + (size_t)kb * 6 * DFF + j0;
            { const bool lo = fr < 2, hi = fr >= 14;
              const f32x4 ga = lo ? acc[ai][0][0][0] : acc[ai][0][3][0], gb = lo ? acc[ai][0][0][1] : acc[ai][0][3][1];
              const f32x4 va = lo ? acc[ai][1][0][0] : acc[ai][1][3][0], vb = lo ? acc[ai][1][0][1] : acc[ai][1][3][1];
              if (lo || hi) { bf16_t* ep = eb + (size_t)(lo ? fr : fr - 12) * DFF; *(u32x4*)ep = (u32x4){pk2(ga[0], ga[1]), pk2(ga[2], ga[3]), pk2(gb[0], gb[1]), pk2(gb[2], gb[3])}; }
              if (fr == 0 || fr == 15) { bf16_t* ep = eb + (size_t)(fr == 0 ? 4 : 5) * DFF; *(u32x4*)ep = (u32x4){pk2(va[0], va[1]), pk2(va[2], va[3]), pk2(vb[0], vb[1]), pk2(vb[2], vb[3])}; } }
#pragma unroll
            for (int n = 0; n < 2; ++n) {
                const f32x4 w0 = *(const f32x4*)(cw + j0 + 4 * n), w1 = *(const f32x4*)(cw + DFF + j0 + 4 * n), w2 = *(const f32x4*)(cw + 2 * DFF + j0 + 4 * n), bs = *(const f32x4*)(cb + j0 + 4 * n);
                f32x4 o[4];
#pragma unroll
                for (int e = 0; e < 4; ++e) {
                    float t[4], sx[4];
#pragma unroll
                    for (int m = 0; m < 4; ++m) { const float gv = acc[ai][0][m][n][e]; t[m] = __shfl(gv, psrc); sx[m] = __shfl(gv, nsrc); }
#pragma unroll
                    for (int m = 0; m < 4; ++m) { const float gv = acc[ai][0][m][n][e];
                        const float prev = (fr == 0) ? (m > 0 ? t[m > 0 ? m - 1 : 0] : 0.f) : t[m];
                        const float next = (fr == 15) ? (m < 3 ? sx[m < 3 ? m + 1 : 3] : 0.f) : sx[m];
                        const float y = w0[e] * prev + w1[e] * gv + w2[e] * next + bs[e];
                        o[m][e] = gelu_f(y) * acc[ai][1][m][n][e]; } }
#pragma unroll
                for (int m = 0; m < 4; ++m) { const int rho = 16 * m + fr;
                    if (rho != 0 && rho != 63) { u32x2 wv; wv.x = pk2(o[m][0], o[m][1]); wv.y = pk2(o[m][2], o[m][3]);
                        *(u32x2*)(act + (size_t)(kb * 64 + rho) * DFF + j0 + 4 * n) = wv; } }
            }
        }
    }
};

struct MergeOrder { pg8::StaticOrder base;
    __device__ bool next(int i, pg8::Unit& u) const { if (!base.next(i >> 1, u)) return false; u.seg = i & 1; return true; }
    __device__ __forceinline__ void a_ready(const pg8::Unit&) const {}
    __device__ __forceinline__ void done(const pg8::Unit&) const {}
};
struct EpiMerge {
    static constexpr bool PERM = true, AFTER_DRAIN = false, CHAIN = true;
    const bf16_t* mg; bf16_t* dstb;
    __device__ __forceinline__ void operator()(f32x4 (&acc)[2][2][4][2], const pg8::Unit& u, int wr, int wc, int fr, int fq) const {
        const int row0 = u.pm * 256 + wr * 64 + fr, col0 = u.pn * 256 + wc * 32 + 8 * fq;
#pragma unroll
        for (int ai = 0; ai < 2; ++ai)
#pragma unroll
            for (int m = 0; m < 4; ++m) { const size_t r = (size_t)(row0 + ai * 128 + m * 16);
#pragma unroll
                for (int bj = 0; bj < 2; ++bj) { const int c = col0 + bj * 128;
                    const unsigned char* gq = (const unsigned char*)mg + r * 4096 + c;
                    const u32x2 gm = *(const u32x2*)(gq + 2048);
                    float qm[8];
#pragma unroll
                    for (int i = 0; i < 8; ++i) qm[i] = (float)((gm[i >> 2] >> (8 * (i & 3))) & 0xffu);
                    if (u.seg == 0) {
                        const u32x2 gn = *(const u32x2*)gq;
#pragma unroll
                        for (int n = 0; n < 2; ++n)
#pragma unroll
                            for (int e = 0; e < 4; ++e) { const float qn = (float)((gn[n] >> (8 * e)) & 0xffu); acc[ai][bj][m][n][e] *= qn * __builtin_amdgcn_rcpf(qm[4 * n + e]); }
                    } else {
                        float o[8];
#pragma unroll
                        for (int n = 0; n < 2; ++n)
#pragma unroll
                            for (int e = 0; e < 4; ++e) o[4 * n + e] = acc[ai][bj][m][n][e] * (qm[4 * n + e] * (1.0f / 255.0f));
                        u32x4 w; w.x = pk2(o[0], o[1]); w.y = pk2(o[2], o[3]); w.z = pk2(o[4], o[5]); w.w = pk2(o[6], o[7]);
                        *(u32x4*)(dstb + r * 2048 + c) = w;
                    } } }
    }
};

__device__ __forceinline__ float wave_sum(float v) {
#pragma unroll
    for (int o = 1; o < 64; o <<= 1) v += __shfl_xor(v, o);
    return v;
}
__device__ __forceinline__ void transpose_item(const float* W, int ldw, int src0, int nvalid, int k0, int K, bf16_t* WT, int drow0, float* scr, int lane) {
    const int n_ = lane & 31;
    float tv[32];
#pragma unroll
    for (int i = 0; i < 32; ++i) { const int kk = 2 * i + (lane >> 5); tv[i] = (n_ < nvalid) ? W[(size_t)(k0 + kk) * ldw + src0 + n_] : 0.f; }
#pragma unroll
    for (int i = 0; i < 32; ++i) { const int kk = 2 * i + (lane >> 5); scr[kk * 33 + n_] = tv[i]; }
    __builtin_amdgcn_s_waitcnt(0); asm volatile("" ::: "memory");
    const int c = lane & 7;
#pragma unroll
    for (int j = 0; j < 4; ++j) { const int n = (lane >> 3) + 8 * j; const float* s = scr + (8 * c) * 33 + n;
        u32x4 o; o.x = pk2(s[0 * 33], s[1 * 33]); o.y = pk2(s[2 * 33], s[3 * 33]); o.z = pk2(s[4 * 33], s[5 * 33]); o.w = pk2(s[6 * 33], s[7 * 33]);
        *(u32x4*)(WT + (size_t)(drow0 + n) * K + k0 + 8 * c) = o; }
    __builtin_amdgcn_s_waitcnt(0); asm volatile("" ::: "memory");
}

__device__ __forceinline__ void phase_prologue(const Params& p, unsigned char* lds) {
    const int tid = threadIdx.x, lane = tid & 63, wave = tid >> 6;
    const int gw = blockIdx.x * NWAVES + wave, NGW = gridDim.x * NWAVES;
    float* scr = (float*)(lds + wave * 16384);
    unsigned char* ws = p.ws;
    constexpr int I_IN = 32 * 360, I_BN = 16 * 64, I_OUT = 32 * 64, I_UP = 32 * 344, I_DN = 86 * 64;
    constexpr int NITEMS = I_IN + 2 * I_BN + I_OUT + I_UP + I_DN;
    for (int it = gw; it < NITEMS; it += NGW) {
        int r = it;
        if (r < I_IN) { const int kb = r / 360, nb = r % 360, n0 = nb * 32; int src0, nv;
            if (n0 < 7168) { src0 = n0; nv = 32; } else if (n0 < 11264) { src0 = n0 + 16; nv = 32; } else if (n0 == 11264) { src0 = 7168; nv = 16; } else { src0 = 0; nv = 0; }
            transpose_item(p.in[1], 11280, src0, nv, kb * 64, 2048, (bf16_t*)(ws + WS_WIN), n0, scr, lane); continue; }
        r -= I_IN;
        if (r < I_BN) { const int kb = r / 64, nb = r % 64; transpose_item(p.in[8], 2048, nb * 32, 32, kb * 64, 1024, (bf16_t*)(ws + WS_WBNA), nb * 32, scr, lane); continue; }
        r -= I_BN;
        if (r < I_BN) { const int kb = r / 64, nb = r % 64; transpose_item(p.in[9], 2048, nb * 32, 32, kb * 64, 1024, (bf16_t*)(ws + WS_WBML), nb * 32, scr, lane); continue; }
        r -= I_BN;
        if (r < I_OUT) { const int kb = r / 64, nb = r % 64; transpose_item(p.in[10], 2048, nb * 32, 32, kb * 64, 2048, (bf16_t*)(ws + WS_WOUT), nb * 32, scr, lane); continue; }
        r -= I_OUT;
        if (r < I_UP) { const int kb = r / 344, nb = r % 344, n0 = nb * 32, pt = n0 >> 8, l0 = n0 & 255;
            const int src0 = (l0 < 128) ? pt * 128 + l0 : DFF + pt * 128 + (l0 - 128);
            transpose_item(p.in[13], NUP, src0, 32, kb * 64, 2048, (bf16_t*)(ws + WS_WUP), n0, scr, lane); continue; }
        r -= I_UP;
        { const int kb = r / 64, nb = r % 64; transpose_item(p.in[16], 2048, nb * 32, 32, kb * 64, DFF, (bf16_t*)(ws + WS_WDN), nb * 32, scr, lane); }
    }
    const float* x = p.in[0]; bf16_t* xb = (bf16_t*)(ws + WS_XB);
    const size_t n8 = (size_t)T * DM / 8, stride = (size_t)gridDim.x * NTHREADS;
    for (size_t i0 = (size_t)blockIdx.x * NTHREADS + tid; i0 < n8; i0 += 4 * stride) {
        f32x4 a[4], b[4];
#pragma unroll
        for (int u = 0; u < 4; ++u) { const size_t i = min(i0 + u * stride, n8 - 1); a[u] = *(const f32x4*)(x + i * 8); b[u] = *(const f32x4*)(x + i * 8 + 4); }
#pragma unroll
        for (int u = 0; u < 4; ++u) { const size_t i = i0 + u * stride; if (i >= n8) continue;
            u32x4 w; w.x = pk2(a[u][0], a[u][1]); w.y = pk2(a[u][2], a[u][3]); w.z = pk2(b[u][0], b[u][1]); w.w = pk2(b[u][2], b[u][3]);
            *(u32x4*)(xb + i * 8) = w; }
    }
}

__device__ __forceinline__ void phase_prep(const Params& p, unsigned char* lds) {
    const int tid = threadIdx.x, lane = tid & 63, wave = tid >> 6;
    unsigned char* ws = p.ws; unsigned char* dout = (unsigned char*)p.out;
    const bf16_t* mlqk = (const bf16_t*)(ws + WS_MLQK); const bf16_t* mlv = (const bf16_t*)(ws + WS_MLV); const bf16_t* naqkv = (const bf16_t*)(ws + WS_NAQKV);
    bf16_t* Qc = (bf16_t*)(ws + WS_QC); bf16_t* Kc = (bf16_t*)(ws + WS_KC);
    bf16_t* KcT = (bf16_t*)(dout + DO_KCT); bf16_t* VTml = (bf16_t*)(dout + DO_VTML); bf16_t* VTna = (bf16_t*)(dout + DO_VTNA);
    const float* cw = p.in[3]; const float* cb = p.in[4];
    unsigned short* tile = (unsigned short*)lds;
    const int tl = tid >> 3, c8 = tid & 7;
    {
        for (int item = blockIdx.x; item < 1024; item += gridDim.x) {
            const int ci = item & 31, h = (item >> 5) & 3, b = item >> 7;
            const size_t tb = (size_t)b * 4096 + 128 * ci;
#pragma unroll 1
            for (int bt = 0; bt < 4; ++bt) {
                u32x4 cur[4], prv[4], nxt[4];
#pragma unroll
                for (int u = 0; u < 4; ++u) { const int i = bt * 4 + u, L = i * 512 + tid, s_ = (L >> 5) & 127, ch = L & 31, cc = (i >> 3) * 1024 + h * 256 + ch * 8, sq = 128 * ci + s_;
                    const bf16_t* sp = mlqk + (tb + s_) * 2048 + cc;
                    cur[u] = *(const u32x4*)sp; prv[u] = (u32x4){0u, 0u, 0u, 0u}; nxt[u] = (u32x4){0u, 0u, 0u, 0u};
                    if (sq > 0) prv[u] = *(const u32x4*)(sp - 2048);
                    if (sq < 4095) nxt[u] = *(const u32x4*)(sp + 2048); }
#pragma unroll
                for (int u = 0; u < 4; ++u) { const int i = bt * 4 + u, L = i * 512 + tid, s_ = (L >> 5) & 127, ch = L & 31, isk = i >> 3, cc = isk * 1024 + h * 256 + ch * 8;
                    float w0[8], w1[8], w2[8], bs[8];
#pragma unroll
                    for (int q = 0; q < 2; ++q) { const f32x4 a0 = *(const f32x4*)(cw + cc + 4 * q), a1 = *(const f32x4*)(cw + 2048 + cc + 4 * q), a2 = *(const f32x4*)(cw + 4096 + cc + 4 * q), a3 = *(const f32x4*)(cb + cc + 4 * q);
#pragma unroll
                        for (int e = 0; e < 4; ++e) { w0[4 * q + e] = a0[e]; w1[4 * q + e] = a1[e]; w2[4 * q + e] = a2[e]; bs[4 * q + e] = a3[e]; } }
                    const float sc = isk ? 0.0625f : 1.0f;
                    float o[8];
#pragma unroll
                    for (int k = 0; k < 4; ++k) {
                        const float yl = w0[2 * k] * bflo(prv[u][k]) + w1[2 * k] * bflo(cur[u][k]) + w2[2 * k] * bflo(nxt[u][k]) + bs[2 * k];
                        const float yh = w0[2 * k + 1] * bfhi(prv[u][k]) + w1[2 * k + 1] * bfhi(cur[u][k]) + w2[2 * k + 1] * bfhi(nxt[u][k]) + bs[2 * k + 1];
                        o[2 * k] = yl * sigmoidf_(yl) * sc; o[2 * k + 1] = yh * sigmoidf_(yh) * sc; }
                    u32x4 wv; wv.x = pk2(o[0], o[1]); wv.y = pk2(o[2], o[3]); wv.z = pk2(o[4], o[5]); wv.w = pk2(o[6], o[7]);
                    *(u32x4*)((isk ? Kc : Qc) + (tb + s_) * 1024 + h * 256 + ch * 8) = wv;
                    }
            }
        }
    }
    const float* gates = (const float*)(ws + WS_GATES);
    float* Bv = (float*)(ws + WS_BV); float* Av = (float*)(ws + WS_AV); float* PMv = (float*)(ws + WS_PMV); float* BL = (float*)(ws + WS_BL); float* AM = (float*)(ws + WS_AM);
    const float* igb = p.in[5]; const float* fgb = p.in[6];
    for (int wi = blockIdx.x * NWAVES + wave; wi < 2048; wi += gridDim.x * NWAVES) {
        const int seq = wi >> 5, c = wi & 31, g = seq >> 5, b = (seq >> 2) & 7, h = seq & 3;
        const int sb = g ? 4096 - 128 * (c + 1) : 128 * c;
        const int p0 = 2 * lane, p1 = p0 + 1, u0 = g ? 127 - p0 : p0, u1 = g ? 127 - p1 : p1;
        const size_t t0 = (size_t)b * 4096 + sb + u0, t1 = (size_t)b * 4096 + sb + u1;
        const float fb = fgb[g * 4 + h], ib = igb[g * 4 + h];
        const float f0 = gates[t0 * 16 + 8 + g * 4 + h] + fb, f1 = gates[t1 * 16 + 8 + g * 4 + h] + fb;
        const float i0 = gates[t0 * 16 + g * 4 + h] + ib, i1 = gates[t1 * 16 + g * 4 + h] + ib;
        const float lf0 = fminf(f0, 0.f) - log1pf(expf(-fabsf(f0))), lf1 = fminf(f1, 0.f) - log1pf(expf(-fabsf(f1)));
        const float s1 = lf0 + lf1;
        float inc = s1;
#pragma unroll
        for (int o = 1; o < 64; o <<= 1) { const float t = __shfl_up(inc, o); if (lane >= o) inc += t; }
        const float ex = inc - s1;
        const float b0 = ex + lf0, b1 = ex + s1;
        const float a0 = i0 - b0, a1 = i1 - b1;
        const float q1 = fmaxf(a0, a1);
        float mi = q1;
#pragma unroll
        for (int o = 1; o < 64; o <<= 1) { const float t = __shfl_up(mi, o); if (lane >= o) mi = fmaxf(mi, t); }
        float exm = __shfl_up(mi, 1); if (lane == 0) exm = -3.0e38f;
        const float pm0 = fmaxf(exm, a0), pm1 = fmaxf(exm, q1);
        const float blast = __shfl(b1, 63), amax = __shfl(mi, 63);
        const size_t so = (size_t)seq * 4096 + sb;
        Bv[so + u0] = b0; Bv[so + u1] = b1; Av[so + u0] = a0; Av[so + u1] = a1; PMv[so + u0] = pm0; PMv[so + u1] = pm1;
        if (lane == 0) { BL[seq * 32 + c] = blast; AM[seq * 32 + c] = amax; }
    }
}

__device__ __forceinline__ void scan_item(const Params& p, int item, unsigned char* lds) {
    const int tid = threadIdx.x, lane = tid & 63, w = tid >> 6, fr = lane & 15, fq = lane >> 4;
    const int seq = item >> 2, es = item & 3, g = seq >> 5, b = (seq >> 2) & 7, h = seq & 3;
    unsigned char* ws = p.ws; unsigned char* dout = (unsigned char*)p.out;
    const bf16_t* Qc = (const bf16_t*)(ws + WS_QC); const bf16_t* Kc = (const bf16_t*)(ws + WS_KC);
    const bf16_t* KcT = (const bf16_t*)(dout + DO_KCT); const bf16_t* VTml = (const bf16_t*)(dout + DO_VTML);
    const float* Bv = (const float*)(ws + WS_BV); const float* Av = (const float*)(ws + WS_AV); const float* PMv = (const float*)(ws + WS_PMV);
    const float* BL = (const float*)(ws + WS_BL); const float* AM = (const float*)(ws + WS_AM);
    bf16_t* Hout = (bf16_t*)(ws + WS_HOUT);
    unsigned short* Cs = (unsigned short*)lds;
    float* mst = (float*)(lds + 43008); float* mnw = mst + 32; float* bls = mst + 64;
    float* SC = (float*)(lds + 43520);
    unsigned char* Ks = lds + 47104;
    unsigned char* Vs = lds + 112640;
    for (int i = tid; i < 80 * 264 / 2; i += NTHREADS) ((unsigned*)Cs)[i] = 0u;
    if (tid == 0) { float m = -1.0e30f;
        for (int c = 0; c < 32; ++c) { const float bl = BL[seq * 32 + c], am = AM[seq * 32 + c]; mst[c] = m; bls[c] = bl; const float mn = fmaxf(bl + m, bl + am); mnw[c] = mn; m = mn; } }
    f32x4 stC[2][5];
#pragma unroll
    for (int dd = 0; dd < 2; ++dd)
#pragma unroll
        for (int et = 0; et < 5; ++et) stC[dd][et] = (f32x4){0.f, 0.f, 0.f, 0.f};
    const u32x4 ones4 = (fr == 0) ? (u32x4){0x3f803f80u, 0x3f803f80u, 0x3f803f80u, 0x3f803f80u} : (u32x4){0u, 0u, 0u, 0u};
    const bf16x8 onesf = __builtin_bit_cast(bf16x8, ones4);
    const size_t seqoff = (size_t)seq * 4096;
    const int ut = 16 * w + fr;
    const int krow0 = tid >> 5, kch = tid & 31, vs0 = tid >> 3, vc16 = tid & 7;
    const bf16_t* kU = Kc + (size_t)b * 4096 * 1024 + h * 256; const unsigned kl = krow0 * 1024 + kch * 8;
    const bf16_t* vU = (const bf16_t*)(ws + WS_MLV) + (size_t)b * 4096 * 1024 + h * 256 + es * 64; const unsigned vl = vs0 * 1024 + vc16 * 8;
    const float* sU = Av + seqoff; const int sl_ = (tid < 128 ? 0 : (tid < 256 ? 262144 : -262144)) + (tid & 127);
    const bf16_t* qU = Qc + (size_t)b * 4096 * 1024 + h * 256; const unsigned ql = ut * 1024 + fq * 8;
    bf16_t* hU = Hout + ((size_t)g * T + (size_t)b * 4096) * 1024 + h * 256 + es * 64; const unsigned hl = ut * 1024 + 4 * fq;
    const int koff = fr * 512, kx0 = ((0 + fq) ^ fr) << 4;
    u32x4 kpre[8], vpre[2]; float spre = 0.f;
    bf16x8 qf[8];
    {   const int sb0 = g ? 4096 - 128 : 0;
#pragma unroll
        for (int i = 0; i < 8; ++i) kpre[i] = *(const u32x4*)(kU + (size_t)(sb0 * 1024 + i * 16384 + kl));
#pragma unroll
        for (int i = 0; i < 2; ++i) vpre[i] = *(const u32x4*)(vU + (size_t)((sb0 + 64 * i) * 1024 + vl));
        if (tid < 384) spre = sU[sb0 + sl_];
        const bf16_t* qrow = qU + (size_t)(sb0 * 1024 + ql);
#pragma unroll
        for (int ks = 0; ks < 8; ++ks) qf[ks] = *(const bf16x8*)(qrow + ks * 32);
    }
#define SCAN_SB() __builtin_amdgcn_sched_barrier(0)
    for (int c = 0; c < 32; ++c) {
        const int sb = g ? 4096 - 128 * (c + 1) : 128 * c;
        const int sbn = g ? 4096 - 128 * (c + 2) : 128 * (c + 1);
        unsigned char* Vc = Vs + (c & 1) * 16384;
        float* SCc = SC + (c & 1) * 384;
#pragma unroll
        for (int i = 0; i < 8; ++i) { const int row = i * 16 + krow0; *(u32x4*)(Ks + row * 512 + ((kch ^ (row & 15)) << 4)) = kpre[i]; }
        int vs_v = vs0, vc_v = vc16; asm volatile("" : "+v"(vs_v), "+v"(vc_v));
#pragma unroll
        for (int i = 0; i < 2; ++i) { const int s_ = 64 * i + vs_v, k2_ = s_ >> 5, sl_ = s_ & 31;
            const int pos_ = (sl_ < 16) ? (sl_ >> 2) * 8 + (sl_ & 3) : ((sl_ - 16) >> 2) * 8 + 4 + (sl_ & 3);
            const int ch_ = k2_ * 4 + (pos_ >> 3), by_ = (pos_ & 7) * 2;
#pragma unroll
            for (int q = 0; q < 8; ++q) { const int e = 8 * vc_v + q; const unsigned wd = vpre[i][q >> 1];
                *(unsigned short*)(Vc + e * 256 + ((ch_ ^ (e & 15)) << 4) + by_) = (unsigned short)((q & 1) ? (wd >> 16) : (wd & 0xffffu)); } }
        if (tid < 384) SCc[tid] = spre;
        __syncthreads();
        const float m_st = mst[c], m_nw = mnw[c], bl = bls[c];
        const float pm_t = SCc[128 + ut], b_t = SCc[256 + ut];
        const float M_t = fmaxf(pm_t, m_st);
        const float winter = __expf(m_st - M_t), eclamp = __expf(-(b_t + M_t));
        bf16x8 pf[4];
        {
            bf16x8 kf[2][2]; f32x4 accp = (f32x4){0.f, 0.f, 0.f, 0.f}; float sg[8];
#pragma unroll
            for (int ks = 0; ks < 2; ++ks) kf[0][ks] = *(const bf16x8*)(Ks + koff + (((ks * 4 + fq) ^ fr) << 4));
#pragma unroll
            for (int st = 0; st < 8; ++st) {
                f32x4 a = (f32x4){0.f, 0.f, 0.f, 0.f};
#pragma unroll
                for (int gq = 0; gq < 4; ++gq) { const int gi = st * 4 + gq;
                    if (gi < 31) { const int st2 = (gi + 1) >> 2, g2 = (gi + 1) & 3;
#pragma unroll
                        for (int ks = 0; ks < 2; ++ks) kf[(gi + 1) & 1][ks] = *(const bf16x8*)(Ks + st2 * 8192 + koff + ((((2 * g2 + ks) * 4 + fq) ^ fr) << 4)); }
                    SCAN_SB();
#pragma unroll
                    for (int ks = 0; ks < 2; ++ks) a = mfma16(kf[gi & 1][ks], qf[2 * gq + ks], a);
                    SCAN_SB();
                }
                if (st > 0) {
                    const int sp = st - 1; const f32x4 av_ = *(const f32x4*)(SCc + 16 * sp + 4 * fq);
#pragma unroll
                    for (int j = 0; j < 4; ++j) { const int us = 16 * sp + 4 * fq + j; const bool ok = g ? (us >= ut) : (us <= ut);
                        const float dwv = ok ? __expf(av_[j] - M_t) : 0.f; sg[4 * (sp & 1) + j] = accp[j] * dwv; }
                    if (sp & 1) { u32x4 wv; wv.x = pk2(sg[0], sg[1]); wv.y = pk2(sg[2], sg[3]); wv.z = pk2(sg[4], sg[5]); wv.w = pk2(sg[6], sg[7]); pf[sp >> 1] = __builtin_bit_cast(bf16x8, wv); }
                }
                accp = a;
            }
            const f32x4 av7 = *(const f32x4*)(SCc + 16 * 7 + 4 * fq);
#pragma unroll
            for (int j = 0; j < 4; ++j) { const int us = 16 * 7 + 4 * fq + j; const bool ok = g ? (us >= ut) : (us <= ut);
                const float dwv = ok ? __expf(av7[j] - M_t) : 0.f; sg[4 + j] = accp[j] * dwv; }
            { u32x4 wv; wv.x = pk2(sg[0], sg[1]); wv.y = pk2(sg[2], sg[3]); wv.z = pk2(sg[4], sg[5]); wv.w = pk2(sg[6], sg[7]); pf[3] = __builtin_bit_cast(bf16x8, wv); }
        }
        if (c + 1 < 32) {
#pragma unroll
            for (int i = 0; i < 8; ++i) kpre[i] = *(const u32x4*)(kU + (size_t)(sbn * 1024 + i * 16384 + kl));
#pragma unroll
            for (int i = 0; i < 2; ++i) vpre[i] = *(const u32x4*)(vU + (size_t)((sbn + 64 * i) * 1024 + vl));
            if (tid < 384) spre = sU[sbn + sl_];
        }
        bf16_t* hp = hU + (size_t)(sb * 1024 + hl);
        float rden = 0.f;
        {
            bf16x8 cf[8], vf[4];
#pragma unroll
            for (int ks = 0; ks < 8; ++ks) cf[ks] = *(const bf16x8*)(Cs + (64 + fr) * 264 + ks * 32 + fq * 8);
#pragma unroll
            for (int ei = 0; ei < 5; ++ei) { const int et = (ei == 0) ? 4 : ei - 1;
                if (et < 4) {
#pragma unroll
                    for (int k2 = 0; k2 < 4; ++k2) vf[k2] = *(const bf16x8*)(Vc + (16 * et + fr) * 256 + (((k2 * 4 + fq) ^ fr) << 4));
                }
                SCAN_SB();
                f32x4 a = (f32x4){0.f, 0.f, 0.f, 0.f};
#pragma unroll
                for (int ks = 0; ks < 8; ++ks) a = mfma16(cf[ks], qf[ks], a);
                SCAN_SB();
                if (ei < 4) {
#pragma unroll
                    for (int ks = 0; ks < 8; ++ks) cf[ks] = *(const bf16x8*)(Cs + (16 * ei + fr) * 264 + ks * 32 + fq * 8);
                }
                a = a * winter;
#pragma unroll
                for (int k2 = 0; k2 < 4; ++k2) a = mfma16(et < 4 ? vf[k2] : onesf, pf[k2], a);
                if (et == 4) { const float den = __shfl(a[0], fr); rden = 1.0f / fmaxf(fabsf(den), eclamp); }
                else { const f32x4 v = a * rden; u32x2 wv; wv.x = pk2(v[0], v[1]); wv.y = pk2(v[2], v[3]); *(u32x2*)(hp + 16 * et) = wv; } }
        }
        u32x2 ktr[2][4][2];
#pragma unroll
        for (int dd = 0; dd < 2; ++dd)
#pragma unroll
            for (int k2 = 0; k2 < 4; ++k2)
#pragma unroll
                for (int hf = 0; hf < 2; ++hf) { const int row = 32 * k2 + 16 * hf + 4 * fq + (fr >> 2), ch = 4 * w + 2 * dd + ((fr & 3) >> 1);
                    typedef short v4i16_t __attribute__((ext_vector_type(4)));
                    const v4i16_t tv = __builtin_amdgcn_ds_read_tr16_b64_v4i16((LAS v4i16_t*)(LAS unsigned char*)(Ks + row * 512 + ((ch ^ (row & 15)) << 4) + 8 * (fr & 1)));
                    ktr[dd][k2][hf] = __builtin_bit_cast(u32x2, tv); }
        __syncthreads();
        const float decay = __expf(bl + m_st - m_nw);
#pragma unroll
        for (int dd = 0; dd < 2; ++dd)
#pragma unroll
            for (int et = 0; et < 5; ++et) stC[dd][et] = stC[dd][et] * decay;
        {
            bf16x8 vf[4]; f32x4 avv[2];
#pragma unroll
            for (int k2 = 0; k2 < 4; ++k2) {
#pragma unroll
                for (int et = 0; et < 4; ++et) vf[et] = *(const bf16x8*)(Vc + (16 * et + fr) * 256 + (((k2 * 4 + fq) ^ fr) << 4));
                avv[0] = *(const f32x4*)(SCc + 32 * k2 + 4 * fq); avv[1] = *(const f32x4*)(SCc + 32 * k2 + 16 + 4 * fq);
                float wsv[8];
#pragma unroll
                for (int hf = 0; hf < 2; ++hf)
#pragma unroll
                    for (int j = 0; j < 4; ++j) wsv[4 * hf + j] = __expf(bl + avv[hf][j] - m_nw);
                bf16x8 kt[2];
#pragma unroll
                for (int dd = 0; dd < 2; ++dd) { const u32x2 lo = ktr[dd][k2][0], hi = ktr[dd][k2][1];
                    u32x4 wv; wv.x = pk2(bflo(lo.x) * wsv[0], bfhi(lo.x) * wsv[1]); wv.y = pk2(bflo(lo.y) * wsv[2], bfhi(lo.y) * wsv[3]);
                    wv.z = pk2(bflo(hi.x) * wsv[4], bfhi(hi.x) * wsv[5]); wv.w = pk2(bflo(hi.y) * wsv[6], bfhi(hi.y) * wsv[7]); kt[dd] = __builtin_bit_cast(bf16x8, wv); }
#pragma unroll
                for (int et = 0; et < 5; ++et) { const bf16x8 vv = et < 4 ? vf[et] : onesf;
                    stC[0][et] = mfma16(vv, kt[0], stC[0][et]); stC[1][et] = mfma16(vv, kt[1], stC[1][et]); }
            }
        }
        if (c + 1 < 32) { const bf16_t* qrow = qU + (size_t)(sbn * 1024 + ql);
#pragma unroll
            for (int ks = 0; ks < 8; ++ks) qf[ks] = *(const bf16x8*)(qrow + ks * 32); }
#pragma unroll
        for (int dd = 0; dd < 2; ++dd)
#pragma unroll
            for (int et = 0; et < 5; ++et)
#pragma unroll
                for (int j = 0; j < 4; j += 2) { const unsigned pw = pk2(stC[dd][et][j], stC[dd][et][j + 1]);
                    Cs[(16 * et + 4 * fq + j) * 264 + 16 * (2 * w + dd) + fr] = (unsigned short)(pw & 0xffffu); Cs[(16 * et + 4 * fq + j + 1) * 264 + 16 * (2 * w + dd) + fr] = (unsigned short)(pw >> 16); }
    }
#undef SCAN_SB
    __syncthreads();
}

__device__ __forceinline__ void na_item(const Params& p, int b, int hd, int r, int j, int lane, const float* rpl, const unsigned char* Vl) {
    const int fr = lane & 15, fq = lane >> 4;
    unsigned char* ws = p.ws; unsigned char* dout = (unsigned char*)p.out;
    const bf16_t* naqkv = (const bf16_t*)(ws + WS_NAQKV); bf16_t* yna = (bf16_t*)(dout + DO_YNA);
    const float* rp = rpl + hd * (15 * 31);
    const int rs = min(max(r - 4, 0), 56), kstart = min(max(16 * j - 8, 0), 32);
    const int qc = 16 * j + fr, wstart = min(max(qc - 8, 0), 48);
    const size_t tokq = (size_t)b * 4096 + r * 64 + qc;
    const bf16_t* qp = naqkv + tokq * 3072 + hd * 64 + fq * 8;
    const bf16x8 q0 = *(const bf16x8*)qp, q1 = *(const bf16x8*)(qp + 32);
    bf16x8 kfr[3][8];
    const bf16_t* kU = naqkv + ((size_t)b * 4096 + rs * 64 + kstart) * 3072 + 1024 + hd * 64; const unsigned kl = fr * 3072 + fq * 8;
#define NA_LOADK(buf, grp) do { _Pragma("unroll") for (int q_ = 0; q_ < 4; ++q_) { const int mt_ = 4 * (grp) + q_; const bf16_t* kp_ = kU + (size_t)(((mt_ >> 1) * 64 + (mt_ & 1) * 16) * 3072 + kl); \
        kfr[buf][2 * q_] = *(const bf16x8*)kp_; kfr[buf][2 * q_ + 1] = *(const bf16x8*)(kp_ + 32); } } while (0)
    NA_LOADK(0, 0); NA_LOADK(1, 1);
    __builtin_amdgcn_sched_barrier(0);
    f32x4 accS[16];
#pragma unroll
    for (int grp = 0; grp < 4; ++grp) {
        if (grp + 2 < 4) NA_LOADK((grp + 2) % 3, grp + 2);
        __builtin_amdgcn_sched_barrier(0);
#pragma unroll
        for (int q = 0; q < 4; ++q) { f32x4 a = (f32x4){0.f, 0.f, 0.f, 0.f}; a = mfma16(kfr[grp % 3][2 * q], q0, a); a = mfma16(kfr[grp % 3][2 * q + 1], q1, a); accS[4 * grp + q] = a; }
        __builtin_amdgcn_sched_barrier(0);
    }
#undef NA_LOADK
    float mx = -1.0e30f;
#pragma unroll
    for (int mt = 0; mt < 16; ++mt)
#pragma unroll
        for (int jj = 0; jj < 4; ++jj) { const int kcol = kstart + (mt & 1) * 16 + 4 * fq + jj; const bool valid = (kcol >= wstart) && (kcol < wstart + 16);
            const int dc = min(max(kcol - qc + 15, 0), 30), dr = rs + (mt >> 1) - r + 7;
            const float sc = valid ? accS[mt][jj] * 0.125f + rp[dr * 31 + dc] : -1.0e30f; accS[mt][jj] = sc; mx = fmaxf(mx, sc); }
    mx = fmaxf(mx, __shfl_xor(mx, 16)); mx = fmaxf(mx, __shfl_xor(mx, 32));
    float sum = 0.f;
    bf16x8 pf[8];
#pragma unroll
    for (int ks = 0; ks < 8; ++ks) { float e[8];
#pragma unroll
        for (int i = 0; i < 8; ++i) { e[i] = __expf(accS[2 * ks + (i >> 2)][i & 3] - mx); sum += e[i]; }
        u32x4 wv; wv.x = pk2(e[0], e[1]); wv.y = pk2(e[2], e[3]); wv.z = pk2(e[4], e[5]); wv.w = pk2(e[6], e[7]); pf[ks] = __builtin_bit_cast(bf16x8, wv); }
    sum += __shfl_xor(sum, 16); sum += __shfl_xor(sum, 32);
    const float rsum = 1.0f / sum;
    const int ca = (((kstart >> 2) + fq) ^ fr) << 3, cb = (((kstart >> 2) + 4 + fq) ^ fr) << 3;
    const int s0 = rs % 11;
#pragma unroll
    for (int dt = 0; dt < 4; ++dt) { f32x4 a = (f32x4){0.f, 0.f, 0.f, 0.f};
        u32x2 va[8], vb[8];
#pragma unroll
        for (int ks = 0; ks < 8; ++ks) { int sl = s0 + ks; sl = (sl >= 11) ? sl - 11 : sl; const unsigned char* vp = Vl + sl * 8192 + (16 * dt + fr) * 128;
            va[ks] = *(const u32x2*)(vp + ca); vb[ks] = *(const u32x2*)(vp + cb); }
#pragma unroll
        for (int ks = 0; ks < 8; ++ks) a = mfma16(mk8(va[ks], vb[ks]), pf[ks], a);
        a = a * rsum; u32x2 wv; wv.x = pk2(a[0], a[1]); wv.y = pk2(a[2], a[3]);
        *(u32x2*)(yna + tokq * 1024 + hd * 64 + 16 * dt + 4 * fq) = wv; }
}
__device__ __forceinline__ void na_wg_item(const Params& p, int wgi, unsigned char* lds, const float* rpl) {
    const int tid = threadIdx.x, lane = tid & 63, wave = tid >> 6;
    const int b = wgi >> 5, hd = (wgi >> 1) & 15, r0 = (wgi & 1) * 32;
    unsigned char* Vl = lds + 32768;
    const bf16_t* vU = (const bf16_t*)(p.ws + WS_NAQKV) + (size_t)b * 4096 * 3072 + 2048 + hd * 64;
    const int col = tid >> 3, c16 = tid & 7;
    const unsigned vl = col * 3072 + c16 * 8;
#define NA_HI(it) (min(max(r0 + 2 * min((it), 15) + 1 - 4, 0), 56) + 8)
#define NA_PUT(row, v) do { unsigned char* rp_ = Vl + ((row) % 11) * 8192 + (col & 3) * 2; _Pragma("unroll") for (int i_ = 0; i_ < 8; ++i_) { const int d_ = 8 * c16 + i_; const unsigned wd_ = (v)[i_ >> 1]; \
        *(unsigned short*)(rp_ + d_ * 128 + (((col >> 2) ^ (d_ & 15)) << 3)) = (unsigned short)((i_ & 1) ? (wd_ >> 16) : (wd_ & 0xffffu)); } } while (0)
    __syncthreads();
    const int lo = min(max(r0 - 4, 0), 56);
    for (int row = lo; row < NA_HI(0); ++row) { const u32x4 v = *(const u32x4*)(vU + (size_t)(row * 64 * 3072 + vl)); NA_PUT(row, v); }
    u32x4 pre[2] = {{0u, 0u, 0u, 0u}, {0u, 0u, 0u, 0u}};
    { const int h0 = NA_HI(0), h1 = NA_HI(1);
#pragma unroll
      for (int n = 0; n < 2; ++n) if (h0 + n < h1) pre[n] = *(const u32x4*)(vU + (size_t)((h0 + n) * 64 * 3072 + vl)); }
#pragma unroll 1
    for (int it = 0; it < 16; ++it) {
        __syncthreads();
        const int h0 = NA_HI(it), h1 = NA_HI(it + 1), h2 = NA_HI(it + 2);
#pragma unroll
        for (int n = 0; n < 2; ++n) if (h0 + n < h1) NA_PUT(h0 + n, pre[n]);
#pragma unroll
        for (int n = 0; n < 2; ++n) if (h1 + n < h2) pre[n] = *(const u32x4*)(vU + (size_t)((h1 + n) * 64 * 3072 + vl));
        na_item(p, b, hd, r0 + 2 * it + (wave >> 2), wave & 3, lane, rpl, Vl);
    }
#undef NA_HI
#undef NA_PUT
}

__device__ __forceinline__ void phase_mlnorm(const Params& p) {
    const int tid = threadIdx.x, lane = tid & 63, wave = tid >> 6;
    unsigned char* ws = p.ws;
    const bf16_t* H0 = (const bf16_t*)(ws + WS_HOUT); const bf16_t* H1 = H0 + (size_t)T * 1024; const unsigned char* mlo = (const unsigned char*)(ws + WS_MLO);
    bf16_t* yml = (bf16_t*)(ws + WS_YML); const float* nw = p.in[7];
    const int NW = gridDim.x * NWAVES;
    for (int w0 = blockIdx.x * NWAVES + wave; w0 < T * 4; w0 += 4 * NW) {
        u32x2 a[4], b[4]; unsigned o[4];
#pragma unroll
        for (int u = 0; u < 4; ++u) { const int wi = min(w0 + u * NW, T * 4 - 1); const size_t off = (size_t)wi * 256 + lane * 4;
            a[u] = *(const u32x2*)(H0 + off); b[u] = *(const u32x2*)(H1 + off); o[u] = *(const unsigned*)(mlo + off); }
#pragma unroll
        for (int u = 0; u < 4; ++u) { const int wi = w0 + u * NW; if (wi >= T * 4) continue; const size_t off = (size_t)wi * 256 + lane * 4;
            float v[4] = {bflo(a[u].x) + bflo(b[u].x), bfhi(a[u].x) + bfhi(b[u].x), bflo(a[u].y) + bflo(b[u].y), bfhi(a[u].y) + bfhi(b[u].y)};
            const float mu = wave_sum((v[0] + v[1]) + (v[2] + v[3])) * (1.0f / 256.0f);
            float q = 0.f;
#pragma unroll
            for (int i = 0; i < 4; ++i) { v[i] -= mu; q += v[i] * v[i]; }
            const float rstd = 1.0f / sqrtf(wave_sum(q) * (1.0f / 256.0f) + LN_EPS);
            const f32x4 nwv = *(const f32x4*)(nw + (wi & 3) * 256 + lane * 4);
            const float og[4] = {(float)(o[u] & 0xffu) * (1.0f / 255.0f), (float)((o[u] >> 8) & 0xffu) * (1.0f / 255.0f), (float)((o[u] >> 16) & 0xffu) * (1.0f / 255.0f), (float)(o[u] >> 24) * (1.0f / 255.0f)};
            u32x2 wv; wv.x = pk2(v[0] * rstd * nwv[0] * og[0], v[1] * rstd * nwv[1] * og[1]); wv.y = pk2(v[2] * rstd * nwv[2] * og[2], v[3] * rstd * nwv[3] * og[3]);
            *(u32x2*)(yml + off) = wv; }
    }
}

__device__ __forceinline__ void phase_ln(const float* res, const bf16_t* br, float* out, const float* gam, const float* bet, bf16_t* xb) {
    const int tid = threadIdx.x, lane = tid & 63, wave = tid >> 6;
    for (int row = blockIdx.x * NWAVES + wave; row < T; row += gridDim.x * NWAVES) {
        const f32x4* xr = (const f32x4*)(res + (size_t)row * DM) + lane; const u32x2* brr = (const u32x2*)(br + (size_t)row * DM) + lane;
        f32x4 v[8]; float s = 0.f;
#pragma unroll
        for (int j = 0; j < 8; ++j) { const f32x4 xv = __builtin_nontemporal_load(xr + 64 * j); const u32x2 bw = __builtin_nontemporal_load(brr + 64 * j);
            v[j] = xv * ALPHA + (f32x4){bflo(bw.x), bfhi(bw.x), bflo(bw.y), bfhi(bw.y)}; s += (v[j][0] + v[j][1]) + (v[j][2] + v[j][3]); }
        const float mu = wave_sum(s) * (1.0f / DM); float q = 0.f;
#pragma unroll
        for (int j = 0; j < 8; ++j) { v[j] = v[j] - mu; q += (v[j][0] * v[j][0] + v[j][1] * v[j][1]) + (v[j][2] * v[j][2] + v[j][3] * v[j][3]); }
        const float rstd = 1.0f / sqrtf(wave_sum(q) * (1.0f / DM) + LN_EPS);
        f32x4* orow = (f32x4*)(out + (size_t)row * DM) + lane;
#pragma unroll
        for (int j = 0; j < 8; ++j) { const f32x4 gv = *((const f32x4*)gam + 64 * j + lane), bv = *((const f32x4*)bet + 64 * j + lane);
            const f32x4 y = v[j] * rstd * gv + bv; __builtin_nontemporal_store(y, orow + 64 * j);
            if (xb) { u32x2 wv; wv.x = pk2(y[0], y[1]); wv.y = pk2(y[2], y[3]); __builtin_nontemporal_store(wv, (u32x2*)(xb + (size_t)row * DM) + 64 * j + lane); } }
    }
}

__device__ __forceinline__ void phase_glu_fix(const Params& p) {
    unsigned char* ws = p.ws;
    const bf16_t* E = (const bf16_t*)(ws + WS_EDGE); bf16_t* act = (bf16_t*)(ws + WS_ACT);
    const float* cw = p.in[14]; const float* cb = p.in[15];
    const int n = 513 * (DFF / 4), stride = (int)gridDim.x * NTHREADS;
    for (int i = (int)blockIdx.x * NTHREADS + (int)threadIdx.x; i < n; i += stride) {
        const int k = i / (DFF / 4), j0 = (i - k * (DFF / 4)) * 4;
        const f32x4 w0 = *(const f32x4*)(cw + j0), w1 = *(const f32x4*)(cw + DFF + j0), w2 = *(const f32x4*)(cw + 2 * DFF + j0), bs = *(const f32x4*)(cb + j0);
        const bool seq_edge = ((64 * k) & 4095) == 0;
        const f32x4 z = (f32x4){0.f, 0.f, 0.f, 0.f};
        const bf16_t* Ea = E + (size_t)(k > 0 ? k - 1 : 0) * 6 * DFF + j0; const bf16_t* Eb = E + (size_t)(k < 512 ? k : 511) * 6 * DFF + j0;
#define EDG4(ptr) ({ const u32x2 w_ = *(const u32x2*)(ptr); (f32x4){bflo(w_.x), bfhi(w_.x), bflo(w_.y), bfhi(w_.y)}; })
        if (k >= 1) {
            const f32x4 gm2 = EDG4(Ea + 2 * DFF), gm1 = EDG4(Ea + 3 * DFF), v = EDG4(Ea + 5 * DFF);
            const f32x4 g0 = (k <= 511 && !seq_edge) ? EDG4(Eb + 0 * DFF) : z;
            const f32x4 y = w0 * gm2 + w1 * gm1 + w2 * g0 + bs;
            u32x2 wv; wv.x = pk2(gelu_f(y[0]) * v[0], gelu_f(y[1]) * v[1]); wv.y = pk2(gelu_f(y[2]) * v[2], gelu_f(y[3]) * v[3]);
            *(u32x2*)(act + (size_t)(64 * k - 1) * DFF + j0) = wv;
        }
        if (k <= 511) {
            const f32x4 gm1 = (k >= 1 && !seq_edge) ? EDG4(Ea + 3 * DFF) : z;
            const f32x4 g0 = EDG4(Eb + 0 * DFF), g1 = EDG4(Eb + 1 * DFF), v = EDG4(Eb + 4 * DFF);
            const f32x4 y = w0 * gm1 + w1 * g0 + w2 * g1 + bs;
            u32x2 wv; wv.x = pk2(gelu_f(y[0]) * v[0], gelu_f(y[1]) * v[1]); wv.y = pk2(gelu_f(y[2]) * v[2], gelu_f(y[3]) * v[3]);
            *(u32x2*)(act + (size_t)(64 * k) * DFF + j0) = wv;
        }
    }
}

#define XB_TMO      128
#define XB_XCNT(j)  (256  + 64 * (j))
#define XB_XSUB(j)  (1280 + 64 * (j))
#define XB_XGEN(j)  (2304 + 64 * (j))
#define XB_TOP      3328
#define XB_TOPGEN   3392
#define XCD_BAR_WORDS 3456
#define XB_SPIN_CAP (1u << 18)

__device__ __forceinline__ unsigned xb_ld(unsigned* p)              { return __hip_atomic_load(p, __ATOMIC_RELAXED, __HIP_MEMORY_SCOPE_AGENT); }
__device__ __forceinline__ unsigned xb_add(unsigned* p, unsigned v) { return __hip_atomic_fetch_add(p, v, __ATOMIC_RELAXED, __HIP_MEMORY_SCOPE_AGENT); }
__device__ __forceinline__ unsigned xb_xcc_id() { return (unsigned)__builtin_amdgcn_s_getreg((3 << 11) | 20) & 0xFu; }
#define XB_SPIN(cond, bar) do { unsigned _sp = 0; while (cond) { __builtin_amdgcn_s_sleep(1); \
    if ((++_sp & 255u) == 0u) { if (xb_ld(&(bar)[XB_TMO])) break; if (_sp > XB_SPIN_CAP) { atomicAdd(&(bar)[XB_TMO], 1u); break; } } } } while (0)

struct XcdBarrier {
    unsigned* bar; unsigned x;
    volatile LAS unsigned* st;
};

__device__ __forceinline__ XcdBarrier xcd_barrier_post(unsigned* bar, volatile LAS unsigned* st) {
    XcdBarrier b; b.bar = bar; b.x = xb_xcc_id(); b.st = st;
    if (threadIdx.x == 0) (void)xb_add(&bar[XB_XCNT(b.x)], 1u);
    return b;
}
__device__ __forceinline__ void xcd_barrier_complete(unsigned* bar, unsigned x, unsigned& nloc, unsigned& nx) {
    const unsigned G = gridDim.x * gridDim.y * gridDim.z;
    unsigned sum, cnt, mine, sp = 0u;
    for (;;) {
        sum = 0u; cnt = 0u; mine = 0u;
#pragma unroll
        for (unsigned j = 0; j < 16; ++j) { const unsigned c = xb_ld(&bar[XB_XCNT(j)]); sum += c; cnt += (c > 0u) ? 1u : 0u; mine = (j == x) ? c : mine; }
        if (sum == G) break;
        __builtin_amdgcn_s_sleep(1);
        if ((++sp & 255u) == 0u) { if (xb_ld(&bar[XB_TMO])) break; if (sp > XB_SPIN_CAP) { atomicAdd(&bar[XB_TMO], 1u); break; } }
    }
    nloc = mine > 0u ? mine : 1u; nx = cnt > 0u ? cnt : 1u;
}

__device__ __forceinline__ void xcd_barrier(const XcdBarrier& b) {
    asm volatile("s_waitcnt vmcnt(0)" ::: "memory");
    __syncthreads();
    if (threadIdx.x == 0) {
        unsigned* bar = b.bar;
        __builtin_amdgcn_s_waitcnt(0);
        unsigned nloc = b.st[0], nx = b.st[1];
        if (nloc == 0u) { xcd_barrier_complete(bar, b.x, nloc, nx); b.st[0] = nloc; b.st[1] = nx; }
        const unsigned old = xb_add(&bar[XB_XSUB(b.x)], 1u);
        const unsigned gen = old / nloc;
        if (old + 1u == (gen + 1u) * nloc) {
            __builtin_amdgcn_fence(__ATOMIC_RELEASE, "agent");
            asm volatile("s_waitcnt vmcnt(0)" ::: "memory");
            const unsigned og = xb_add(&bar[XB_TOP], 1u);
            const unsigned tg = og / nx;
            if (og + 1u == (tg + 1u) * nx) xb_add(&bar[XB_TOPGEN], 1u);
            else XB_SPIN(xb_ld(&bar[XB_TOPGEN]) == tg, bar);
            __builtin_amdgcn_fence(__ATOMIC_ACQUIRE, "agent");
            xb_add(&bar[XB_XGEN(b.x)], 1u);
            asm volatile("s_waitcnt vmcnt(0)" ::: "memory");
        } else {
            XB_SPIN(xb_ld(&bar[XB_XGEN(b.x)]) == gen, bar);
            __builtin_amdgcn_fence(__ATOMIC_ACQUIRE, "agent");
            asm volatile("s_waitcnt vmcnt(0)" ::: "memory");
        }
    }
    __syncthreads();
}


__global__ void __launch_bounds__(NTHREADS, 2) fwd_kernel(Params p) {
    extern __shared__ __attribute__((aligned(16))) unsigned char lds[];
    unsigned char* ws = p.ws; unsigned char* dout = (unsigned char*)p.out;
    const int G = gridDim.x, cid = blockIdx.x;
    PG8_LAS unsigned char* ring = (PG8_LAS unsigned char*)lds;
#define RUN(k) (p.ph_lo <= (k) && (k) < p.ph_hi)
    {   volatile LAS unsigned* misc = (volatile LAS unsigned*)((LAS unsigned char*)lds + 147392);
        if (threadIdx.x < 16) misc[threadIdx.x] = 0u;
        __syncthreads(); }
    const XcdBarrier xbar = xcd_barrier_post((unsigned*)ws + p.li * XCD_BAR_WORDS, (volatile LAS unsigned*)((LAS unsigned char*)lds + 147392 + 32));
#define SEAM(k) do { if (RUN(k) && RUN((k) + 1)) { if ((k) == 0) cg::this_grid().sync(); else xcd_barrier(xbar); } } while (0)
    if (RUN(0)) phase_prologue(p, lds);
    SEAM(0);
    if (RUN(1)) {
        pg8::Gemm g{(const bf16_t*)(ws + WS_XB), (const bf16_t*)(ws + WS_WIN), T, N1, DM}; pg8::StaticOrder S; S.init(T, N1, G, cid);
        EpiProj E{(bf16_t*)(ws + WS_NAQKV), (bf16_t*)(ws + WS_MLQK), (bf16_t*)(ws + WS_MLV), (bf16_t*)(ws + WS_MLO), (bf16_t*)(ws + WS_MG), (float*)(ws + WS_GATES)};
        pg8::gemm_phase<EpiProj, pg8::StaticOrder, true, true>(ring, g, S, E);
    }
    SEAM(1);
    if (RUN(2)) phase_prep(p, lds);
    SEAM(2);
    if (RUN(3)) {
        const int vcu = (G % 8 == 0) ? (cid & 7) * (G >> 3) + (cid >> 3) : cid;
        if (p.flags & 1) for (int v = vcu; v < 256; v += G) { const int bh = v >> 3, g_ = (v >> 2) & 1, es_ = v & 3; scan_item(p, (g_ * 32 + bh) * 4 + es_, lds); }
        const int lane = threadIdx.x & 63, wave = threadIdx.x >> 6;
        if (p.flags & 2) {
            float* rpl = (float*)lds;
            for (int i = threadIdx.x; i < 16 * 15 * 31; i += NTHREADS) rpl[i] = p.in[2][i];
            __syncthreads();
            for (int wgi = vcu; wgi < 256; wgi += G) na_wg_item(p, wgi, lds, rpl);
        }
    }
    SEAM(3);
    if (RUN(4)) phase_mlnorm(p);
    SEAM(4);
    if (RUN(5)) {
        pg8::Gemm g{(const bf16_t*)(dout + DO_YNA), (const bf16_t*)(ws + WS_WBNA), T, DM, 1024, (const bf16_t*)(ws + WS_YML), (const bf16_t*)(ws + WS_WBML)};
        MergeOrder S; S.base.init(T, DM, G, cid);
        EpiMerge E{(const bf16_t*)(ws + WS_MG), (bf16_t*)(ws + WS_MIXED)};
        pg8::gemm_phase<EpiMerge, MergeOrder, true, true>(ring, g, S, E);
    }
    SEAM(6);
    if (RUN(7)) {
        pg8::Gemm g{(const bf16_t*)(ws + WS_MIXED), (const bf16_t*)(ws + WS_WOUT), T, DM, DM}; pg8::StaticOrder S; S.init(T, DM, G, cid);
        EpiPlainBf16 E{(bf16_t*)(ws + WS_BR1), DM};
        pg8::gemm_phase<EpiPlainBf16, pg8::StaticOrder, true, true>(ring, g, S, E);
    }
    SEAM(7);
    if (RUN(8)) phase_ln(p.in[0], (const bf16_t*)(ws + WS_BR1), p.out, p.in[11], p.in[12], (bf16_t*)(ws + WS_X1B));
    SEAM(8);
    if (RUN(9)) {
        pg8::Gemm g{(const bf16_t*)(ws + WS_X1B), (const bf16_t*)(ws + WS_WUP), T, NUP, DM}; pg8::StaticOrder S; S.init(T, NUP, G, cid);
        EpiGlu E{(bf16_t*)(ws + WS_ACT), (bf16_t*)(ws + WS_EDGE), p.in[14], p.in[15]};
        pg8::gemm_phase<EpiGlu, pg8::StaticOrder, true, true>(ring, g, S, E);
    }
    SEAM(9);
    if (RUN(10)) phase_glu_fix(p);
    SEAM(10);
    if (RUN(11)) {
        pg8::Gemm g{(const bf16_t*)(ws + WS_ACT), (const bf16_t*)(ws + WS_WDN), T, DM, DFF}; pg8::StaticOrder S; S.init(T, DM, G, cid);
        EpiPlainBf16 E{(bf16_t*)(ws + WS_BR2), DM};
        pg8::gemm_phase<EpiPlainBf16, pg8::StaticOrder, true, true>(ring, g, S, E);
    }
    SEAM(11);
    if (RUN(12)) phase_ln(p.out, (const bf16_t*)(ws + WS_BR2), p.out, p.in[17], p.in[18], nullptr);
#undef RUN
#undef SEAM
}

extern "C" void kernel_launch(void* const* d_in, const int* in_sizes, int n_in, void* d_out, int out_size, void* d_ws, size_t ws_size, hipStream_t stream) {
    static int grid = 0;
    if (grid == 0) {
        if (n_in != 19 || out_size != T * DM || ws_size < WS_END) { fprintf(stderr, "kernel_launch: unexpected shapes (n_in %d out %d ws %zu)\n", n_in, out_size, ws_size); grid = -1; return; }
        int dev = 0, cus = 0, per_cu = 0;
        hipGetDevice(&dev); hipDeviceGetAttribute(&cus, hipDeviceAttributeMultiprocessorCount, dev);
        hipFuncSetAttribute((const void*)fwd_kernel, hipFuncAttributeMaxDynamicSharedMemorySize, LDS_BYTES);
        hipOccupancyMaxActiveBlocksPerMultiprocessor(&per_cu, (const void*)fwd_kernel, NTHREADS, LDS_BYTES);
        if (per_cu < 1) { fprintf(stderr, "kernel_launch: occupancy query says %d blocks per CU\n", per_cu); per_cu = 1; }
        (void)hipGetLastError();
        grid = cus;
    }
    if (grid < 0) return;
    Params p{};
    for (int i = 0; i < 19; ++i) p.in[i] = (const float*)d_in[i];
    p.out = (float*)d_out; p.ws = (unsigned char*)d_ws;
    p.flags = 3; p.li = 0;
    (void)hipMemsetAsync(d_ws, 0, 65536, stream);
#if defined(PROBE_PHASE)
    const int cuts[4] = {0, PROBE_PHASE + 1, PROBE_PHASE + 1, NPHASE}; const int los[3] = {0, PROBE_PHASE, PROBE_PHASE + 1};
    for (int k = 0; k < 3; ++k) { p.ph_lo = los[k]; p.ph_hi = (k == 0) ? cuts[1] : (k == 1 ? PROBE_PHASE + 1 : NPHASE); p.flags = (k == 1) ? PROBE_FLAGS : 3; p.li = k; if (p.ph_lo >= p.ph_hi) continue; void* args[] = {&p};
        hipError_t e = hipLaunchCooperativeKernel((const void*)fwd_kernel, dim3(grid), dim3(NTHREADS), args, LDS_BYTES, stream);
        if (e != hipSuccess) fprintf(stderr, "launch %d failed: %s\n", k, hipGetErrorString(e)); }
#elif MK_N_LAUNCHES == 1
    p.ph_lo = 0; p.ph_hi = NPHASE;
    void* args[] = {&p};
    hipError_t e = hipLaunchCooperativeKernel((const void*)fwd_kernel, dim3(grid), dim3(NTHREADS), args, LDS_BYTES, stream);
    if (e != hipSuccess) fprintf(stderr, "cooperative launch failed: %s (grid %d)\n", hipGetErrorString(e), grid);
#else
    for (int k = 0; k < NPHASE; ++k) { p.ph_lo = k; p.ph_hi = k + 1; void* args[] = {&p};
        hipError_t e = hipLaunchCooperativeKernel((const void*)fwd_kernel, dim3(grid), dim3(NTHREADS), args, LDS_BYTES, stream);
        if (e != hipSuccess) fprintf(stderr, "launch %d failed: %s\n", k, hipGetErrorString(e)); }
#endif
}
```
